# Optimizing an MI355X kernel written in HIP

```python
import math
import jax, jax.numpy as jnp
from jax import lax
import numpy as np

D_MODEL = 1024
BATCH = 32
SEQ = 2048
DEPTH = 2

HEAD_DIM = 64
N_MIX_HEADS = D_MODEL // HEAD_DIM
CONV_WIDTH = D_MODEL // 4
CONV_GROUPS = CONV_WIDTH // HEAD_DIM
RET_HEADS = (N_MIX_HEADS - CONV_GROUPS) // 2
MOBA_HEADS = N_MIX_HEADS - CONV_GROUPS - RET_HEADS
RET_WIDTH = RET_HEADS * HEAD_DIM
MOBA_WIDTH = MOBA_HEADS * HEAD_DIM
IN_COLS = 4 * RET_WIDTH + 3 * MOBA_WIDTH + 3 * CONV_WIDTH
CONV_K = 3
RET_CHUNK = 128
MOBA_BLOCK = 256
MOBA_TOPK = 3
MOBA_Q_CHUNK = 16
REL_BUCKETS = 32
REL_MAX_DIST = 128
ROPE_BASE = 10000.0
D_FF = 256 * ((8 * D_MODEL // 3 + 255) // 256)
DN_ALPHA = (2.0 * DEPTH) ** 0.25
DN_BETA = (8.0 * DEPTH) ** -0.25
LN_EPS = 1e-5

kernel_name = "hybrid_retention_moba_shortconv_deepnorm"

F32 = jnp.float32


def layer_norm(x, g, b):
    xf = x.astype(F32)
    mu = jnp.mean(xf, axis=-1, keepdims=True)
    var = jnp.mean(jnp.square(xf - mu), axis=-1, keepdims=True)
    y = (xf - mu) * lax.rsqrt(var + LN_EPS)
    return (y * g.astype(F32) + b.astype(F32)).astype(x.dtype)


def causal_dwconv(x, w):
    K = w.shape[0]
    S = x.shape[1]
    xp = jnp.pad(x, ((0, 0), (K - 1, 0), (0, 0)))
    y = xp[:, 0:S] * w[0]
    for i in range(1, K):
        y = y + xp[:, i:i + S] * w[i]
    return y


def split_heads(t, n_heads):
    B, S, _ = t.shape
    return t.reshape(B, S, n_heads, HEAD_DIM).transpose(0, 2, 1, 3)


def merge_heads(t):
    B, H, S, dh = t.shape
    return t.transpose(0, 2, 1, 3).reshape(B, S, H * dh)


def rotary(t):
    S, dh = t.shape[2], t.shape[3]
    inv = ROPE_BASE ** (-jnp.arange(0, dh, 2, dtype=F32) / dh)
    ang = jnp.arange(S, dtype=F32)[:, None] * inv[None, :]
    cos, sin = jnp.cos(ang), jnp.sin(ang)
    t1, t2 = t[..., : dh // 2], t[..., dh // 2:]
    return jnp.concatenate([t1 * cos - t2 * sin, t1 * sin + t2 * cos], axis=-1)


def retention(q, k, v):
    B, H, S, dh = q.shape
    C = RET_CHUNK
    n = S // C
    log_g = jnp.log(1.0 - 2.0 ** (-5.0 - jnp.arange(H, dtype=F32)))
    idx = jnp.arange(C, dtype=F32)
    diff = idx[:, None] - idx[None, :]
    decay = jnp.where(diff >= 0, jnp.exp(jnp.maximum(diff, 0.0)[None] * log_g[:, None, None]), 0.0)
    xi = jnp.exp((idx + 1.0)[None, :] * log_g[:, None])
    zeta = jnp.exp((C - 1.0 - idx)[None, :] * log_g[:, None])
    g_chunk = jnp.exp(C * log_g)

    def to_chunks(t):
        return t.reshape(B, H, n, C, dh).transpose(2, 0, 1, 3, 4)

    def step(state, qkv):
        qc, kc, vc = qkv
        scores = jnp.einsum('bhcd,bhed->bhce', qc, kc) * decay[None]
        inner = jnp.einsum('bhce,bhev->bhcv', scores, vc)
        cross = jnp.einsum('bhcd,bhdv->bhcv', qc, state) * xi[None, :, :, None]
        state = state * g_chunk[None, :, None, None] + jnp.einsum(
            'bhcd,bhcv->bhdv', kc * zeta[None, :, :, None], vc)
        return state, inner + cross

    state0 = jnp.zeros((B, H, dh, dh), F32)
    _, out = lax.scan(step, state0, (to_chunks(q), to_chunks(k), to_chunks(v)))
    return out.transpose(1, 2, 0, 3, 4).reshape(B, H, S, dh)


def t5_bucket(dist):
    n = jnp.maximum(dist, 0)
    max_exact = REL_BUCKETS // 2
    nf = jnp.maximum(n, 1).astype(F32)
    large = max_exact + (jnp.log(nf / max_exact) / math.log(REL_MAX_DIST / max_exact)
                         * (REL_BUCKETS - max_exact)).astype(jnp.int32)
    large = jnp.minimum(large, REL_BUCKETS - 1)
    return jnp.where(n < max_exact, n, large)


def moba_attention(q, k, v, rel_bias):
    B, H, S, dh = q.shape
    L = MOBA_BLOCK
    nb = -(-S // L)
    pad = nb * L - S
    kp = jnp.pad(k, ((0, 0), (0, 0), (0, pad), (0, 0))).reshape(B, H, nb, L, dh)
    vp = jnp.pad(v, ((0, 0), (0, 0), (0, pad), (0, 0))).reshape(B, H, nb, L, dh)
    k_mean = jnp.mean(kp, axis=3)
    topk = min(MOBA_TOPK, nb)
    scale = dh ** -0.5
    rel_t = rel_bias.T.astype(F32)
    bi = jnp.arange(B)[:, None, None, None]
    hi = jnp.arange(H)[None, :, None, None]
    Qc = MOBA_Q_CHUNK
    nc = S // Qc
    q_chunks = q.reshape(B, H, nc, Qc, dh).transpose(2, 0, 1, 3, 4)

    def attend(args):
        qi, ci = args
        q_pos = ci * Qc + jnp.arange(Qc, dtype=jnp.int32)
        own = (ci * Qc) // L
        gate = jnp.einsum('bhqd,bhnd->bhqn', qi, k_mean)
        gate = jnp.where(jnp.arange(nb) < own, gate, -jnp.inf)
        _, sel = lax.top_k(gate, topk)
        sel_valid = jnp.arange(topk) < own
        kg = kp[bi, hi, sel]
        vg = vp[bi, hi, sel]
        k_pos_sel = sel[..., None] * L + jnp.arange(L, dtype=jnp.int32)
        b_sel = rel_t[hi[..., None], t5_bucket(q_pos[:, None, None] - k_pos_sel)]
        s_sel = jnp.einsum('bhqd,bhqjld->bhqjl', qi, kg) * scale + b_sel
        s_sel = jnp.where(sel_valid[:, None], s_sel, -jnp.inf)
        k_own = lax.dynamic_index_in_dim(kp, own, axis=2, keepdims=False)
        v_own = lax.dynamic_index_in_dim(vp, own, axis=2, keepdims=False)
        k_pos_own = own * L + jnp.arange(L, dtype=jnp.int32)
        dist_own = q_pos[:, None] - k_pos_own[None, :]
        b_own = rel_t[:, t5_bucket(dist_own)]
        s_own = jnp.einsum('bhqd,bhld->bhql', qi, k_own) * scale + b_own[None]
        s_own = jnp.where(dist_own >= 0, s_own, -jnp.inf)
        logits = jnp.concatenate([s_sel.reshape(B, H, Qc, topk * L), s_own], axis=-1)
        p = jax.nn.softmax(logits, axis=-1)
        p_sel = p[..., : topk * L].reshape(B, H, Qc, topk, L)
        p_own = p[..., topk * L:]
        return (jnp.einsum('bhqjl,bhqjld->bhqd', p_sel, vg)
                + jnp.einsum('bhql,bhld->bhqd', p_own, v_own))

    out = lax.map(attend, (q_chunks, jnp.arange(nc, dtype=jnp.int32)))
    return out.transpose(1, 2, 0, 3, 4).reshape(B, H, S, dh)


def head_group_norm(t):
    mu = jnp.mean(t, axis=-1, keepdims=True)
    var = jnp.mean(jnp.square(t - mu), axis=-1, keepdims=True)
    return (t - mu) * lax.rsqrt(var + LN_EPS)


def hybrid_mixer(h, w_in, conv_w, w_out, rel_bias):
    proj = h @ w_in
    o = np.cumsum([0, RET_WIDTH, RET_WIDTH, RET_WIDTH, RET_WIDTH,
                   MOBA_WIDTH, MOBA_WIDTH, MOBA_WIDTH, CONV_WIDTH, CONV_WIDTH, CONV_WIDTH])
    parts = [proj[..., int(o[i]):int(o[i + 1])] for i in range(10)]
    rq, rk, rv, rg, mq, mk, mv, cb, cc, ch = parts
    scale = HEAD_DIM ** -0.5
    q_r = rotary(split_heads(rq, RET_HEADS).astype(F32))
    k_r = rotary(split_heads(rk, RET_HEADS).astype(F32)) * scale
    v_r = split_heads(rv, RET_HEADS).astype(F32)
    y_ret = merge_heads(head_group_norm(retention(q_r, k_r, v_r))) * jax.nn.silu(rg.astype(F32))
    y_moba = merge_heads(moba_attention(split_heads(mq, MOBA_HEADS).astype(F32),
                                        split_heads(mk, MOBA_HEADS).astype(F32),
                                        split_heads(mv, MOBA_HEADS).astype(F32), rel_bias))
    y_conv = cb.astype(F32) * causal_dwconv(cc.astype(F32) * ch.astype(F32), conv_w.astype(F32))
    cat = jnp.concatenate([y_ret, y_moba, y_conv], axis=-1).astype(h.dtype)
    return cat @ w_out


def conv_ffn(h, w_up, ffn_conv_w, w_down):
    u = h @ w_up
    a, b = u[..., :D_FF], u[..., D_FF:]
    a = causal_dwconv(a, ffn_conv_w)
    return (jax.nn.gelu(a.astype(F32), approximate=False) * b.astype(F32)).astype(h.dtype) @ w_down


def setup_inputs(seed: int = 0) -> dict:
    key = jax.random.key(seed)
    ks = jax.random.split(key, 12)
    nrm = jax.random.normal
    x = nrm(ks[0], (BATCH, SEQ, D_MODEL), F32)
    w_in = nrm(ks[1], (DEPTH, D_MODEL, IN_COLS), F32) * D_MODEL ** -0.5
    conv_w = nrm(ks[2], (DEPTH, CONV_K, CONV_WIDTH), F32) * CONV_K ** -0.5
    w_out = nrm(ks[3], (DEPTH, D_MODEL, D_MODEL), F32) * (D_MODEL ** -0.5 * DN_BETA)
    ln1_g = 1.0 + 0.02 * nrm(ks[4], (DEPTH, D_MODEL), F32)
    ln1_b = 0.02 * nrm(ks[5], (DEPTH, D_MODEL), F32)
    w_up = nrm(ks[6], (DEPTH, D_MODEL, 2 * D_FF), F32) * D_MODEL ** -0.5
    ffn_conv_w = nrm(ks[7], (DEPTH, CONV_K, D_FF), F32) * CONV_K ** -0.5
    w_down = nrm(ks[8], (DEPTH, D_FF, D_MODEL), F32) * (D_FF ** -0.5 * DN_BETA)
    ln2_g = 1.0 + 0.02 * nrm(ks[9], (DEPTH, D_MODEL), F32)
    ln2_b = 0.02 * nrm(ks[10], (DEPTH, D_MODEL), F32)
    rel_bias = 0.2 * nrm(ks[11], (REL_BUCKETS, MOBA_HEADS), F32)
    return {"x": x, "w_in": w_in, "conv_w": conv_w, "w_out": w_out,
            "ln1_g": ln1_g, "ln1_b": ln1_b, "w_up": w_up, "ffn_conv_w": ffn_conv_w,
            "w_down": w_down, "ln2_g": ln2_g, "ln2_b": ln2_b, "rel_bias": rel_bias}


def reference(x, w_in, conv_w, w_out, ln1_g, ln1_b, w_up, ffn_conv_w, w_down, ln2_g, ln2_b, rel_bias):
    for l in range(DEPTH):
        mix = hybrid_mixer(x, w_in[l], conv_w[l], w_out[l], rel_bias)
        x = layer_norm(DN_ALPHA * x + mix, ln1_g[l], ln1_b[l])
        f = conv_ffn(x, w_up[l], ffn_conv_w[l], w_down[l])
        x = layer_norm(DN_ALPHA * x + f, ln2_g[l], ln2_b[l])
    return x
```

```cpp
#include <hip/hip_runtime.h>
#include <hip/hip_cooperative_groups.h>
#include <cstdio>
#include <cstdint>
namespace cg = cooperative_groups;
namespace pg8 {
#define PG8_LAS __attribute__((address_space(3)))
typedef unsigned short bf16_t;
typedef short bf16x8 __attribute__((ext_vector_type(8)));
typedef float f32x4 __attribute__((ext_vector_type(4)));
typedef unsigned u32x4 __attribute__((ext_vector_type(4)));
constexpr int BM = 256, BK = 64, HALF = 128, HTB = HALF * BK * 2  , STAGE_BYTES = 8 * HTB, NXCD = 8, WGM = 8;

__host__ __device__ __forceinline__ int lds_byte(int r, int c) { const int st = (r >> 4) * 2 + (c >> 5), rr = r & 15, cc = c & 31, ob = rr * 64 + cc * 2; return st * 1024 + (ob ^ (((ob >> 9) & 1) << 5)); }
__host__ __device__ __forceinline__ void stage_rc(int b, int& R, int& C) { const int st = b / 1024, sb = b % 1024, swz = sb ^ (((sb >> 9) & 1) << 5); R = (st >> 1) * 16 + swz / 64; C = (st & 1) * 32 + (swz % 64) / 2; }
__host__ __device__ __forceinline__ int perm32(int rho) { const int n = rho >> 4, i = rho & 15; return 8 * (i >> 2) + 4 * n + (i & 3); }

struct Unit { int pm, pn; };
struct Gemm { const bf16_t* A; const bf16_t* Bt; int M, N, K, lda; };

struct StaticOrder {
    int nM, nN, nwg, G, c;
    __host__ __device__ void init(int M, int N, int G_, int c_) { nM = M / BM; nN = N / BM; nwg = nM * nN; G = G_; c = c_; }
    __host__ __device__ bool next(int i, Unit& u) const {
        const long L = (long)i * G + c; if (L >= nwg) return false;
        int wgid = (int)L; { const int q = nwg / NXCD, r = nwg % NXCD, xcd = wgid % NXCD, off = wgid / NXCD; wgid = (xcd < r ? xcd * (q + 1) : r * (q + 1) + (xcd - r) * q) + off; }
        const int nig = WGM * nN, gid = wgid / nig, fm = gid * WGM, gsz = (nM - fm) < WGM ? (nM - fm) : WGM;
        u.pm = fm + ((wgid % nig) % gsz); u.pn = (wgid % nig) / gsz; return true;
    }
    __device__ __forceinline__ void a_ready(const Unit&) const {}
    __device__ __forceinline__ void done(const Unit&) const {}
};
__device__ __forceinline__ unsigned cvt_pk_bf16(float lo, float hi) { unsigned r; asm volatile("v_cvt_pk_bf16_f32 %0, %1, %2" : "=v"(r) : "v"(lo), "v"(hi)); return r; }
typedef float f32x2 __attribute__((ext_vector_type(2)));
__device__ __forceinline__ f32x2 gelu_pk(f32x2 v) {
    const f32x2 av = __builtin_elementwise_abs(v), d = av * 0.2316418882f + 1.0f;
    f32x2 t; t.x = __builtin_amdgcn_rcpf(d.x); t.y = __builtin_amdgcn_rcpf(d.y);
    f32x2 q = t * 0.5307027145f + (-0.7265760135f); q = q * t + 0.7107068705f; q = q * t + (-0.142248368f); q = q * t + 0.127414796f; q = q * t;
    const f32x2 s = (v * v) * (-0.72134752044f);
    f32x2 e; e.x = __builtin_amdgcn_exp2f(s.x); e.y = __builtin_amdgcn_exp2f(s.y);
    const f32x2 m = v * (q * e), r = v - m;
    f32x2 o; o.x = v.x < 0.f ? m.x : r.x; o.y = v.y < 0.f ? m.y : r.y; return o;
}
template <int ACT  > struct EpiBf16 {
    static constexpr bool PERM = true, AFTER_DRAIN = false;
    bf16_t* O; int ldc; const float* bias; int split_cols; size_t split_stride;
    __device__ __forceinline__ void operator()(const f32x4 (&acc)[2][2][4][2], const Unit& u, int wr, int wc, int fr, int fq) const {
        const int row0 = u.pm * BM + wr * 64 + fr; int colt = u.pn * BM; bf16_t* base = O;
        if (split_cols) { const int t = colt / split_cols; base += (size_t)t * split_stride; colt -= t * split_cols; }
        const int col0 = colt + wc * 32 + 8 * fq, bcol0 = u.pn * BM + wc * 32 + 8 * fq;
        f32x4 bv[2][2];
#pragma unroll
        for (int bj = 0; bj < 2; ++bj)
#pragma unroll
            for (int n = 0; n < 2; ++n) bv[bj][n] = bias ? *(const f32x4*)(bias + bcol0 + bj * HALF + 4 * n) : (f32x4){0.f, 0.f, 0.f, 0.f};
#pragma unroll
        for (int ai = 0; ai < 2; ++ai)
#pragma unroll
            for (int m = 0; m < 4; ++m) { bf16_t* rowp = base + (size_t)(row0 + ai * HALF + m * 16) * ldc + col0;
#pragma unroll
                for (int bj = 0; bj < 2; ++bj) { f32x4 v0 = acc[ai][bj][m][0] + bv[bj][0], v1 = acc[ai][bj][m][1] + bv[bj][1];
                    if (ACT == 1) { f32x2 a = gelu_pk((f32x2){v0[0], v0[1]}), b = gelu_pk((f32x2){v0[2], v0[3]}), c = gelu_pk((f32x2){v1[0], v1[1]}), d = gelu_pk((f32x2){v1[2], v1[3]});
                        v0 = (f32x4){a.x, a.y, b.x, b.y}; v1 = (f32x4){c.x, c.y, d.x, d.y}; }
                    if (ACT == 2) {
#pragma unroll
                        for (int j = 0; j < 4; ++j) { v0[j] = 0.5f * v0[j] * (1.0f + erff(v0[j] * 0.70710678f)); v1[j] = 0.5f * v1[j] * (1.0f + erff(v1[j] * 0.70710678f)); } }
                    u32x4 w; w.x = cvt_pk_bf16(v0[0], v0[1]); w.y = cvt_pk_bf16(v0[2], v0[3]); w.z = cvt_pk_bf16(v1[0], v1[1]); w.w = cvt_pk_bf16(v1[2], v1[3]);
                    *(u32x4*)(rowp + bj * HALF) = w; } }
    }
};
template <class Epi, class Sched, bool STAMP = false>
__device__ __forceinline__ void gemm_phase(PG8_LAS unsigned char* lds, const Gemm g, const Sched& S, const Epi& E, unsigned long long* stamps, const int tid) {
    const int  wid = __builtin_amdgcn_readfirstlane(tid >> 6), lane = tid & 63, wr = wid >> 2, wc = wid & 3, fr = lane & 15, fq = lane >> 4;
    const int K = g.K, nt = K / BK;
    int ts_lo = 0, ts_hi = 0, nts = 0; const unsigned long long rt_entry = STAMP ? (unsigned long long)wall_clock64() : 0ull;
#define PG8_STAMP() do { if (STAMP && wid == 0 && nts < 64) { const unsigned long long _c = (unsigned long long)clock64(); \
        ts_lo = (lane == nts) ? (int)(unsigned)_c : ts_lo; ts_hi = (lane == nts) ? (int)(unsigned)(_c >> 32) : ts_hi; ++nts; } } while (0)
    PG8_STAMP();
    unsigned voffA[2], voffB[2];
#pragma unroll
    for (int i = 0; i < 2; ++i) { int R, C; stage_rc(tid * 16 + i * 8192, R, C); const int Rb = Epi::PERM ? ((R & ~31) + perm32(R & 31)) : R;
        voffA[i] = (unsigned)(R * g.lda + C) * 2u; voffB[i] = (unsigned)(Rb * K + C) * 2u; }
    const size_t kstep = (size_t)(BK * 2);
    const size_t hstep = (size_t)HALF * K * 2; const size_t hstepA = (size_t)HALF * g.lda * 2; const size_t tstepA = 2 * hstepA;
    const size_t tstep = 2 * hstep;
    const unsigned ldsw = (unsigned)wid * 1024u;
    const int aoff = lds_byte(wr * 64 + fr, fq * 8), boff = lds_byte(wc * 32 + fr, fq * 8);
#define PG8_SA(b, h) (((b) * 2 + (h)) * HTB)
#define PG8_SB(b, h) ((4 + (b) * 2 + (h)) * HTB)
#define PG8_STAGE(bufoff, gbase, voff) do { _Pragma("unroll") for (int _i = 0; _i < 2; ++_i) \
        __builtin_amdgcn_global_load_lds((const unsigned*)((const char*)(gbase) + (voff)[_i]), (PG8_LAS unsigned*)(lds + (bufoff) + ldsw + _i * 8192), 16, 0, 0); } while (0)
#define PG8_LDA(dst, b, h) do { _Pragma("unroll") for (int m = 0; m < 4; ++m) _Pragma("unroll") for (int k = 0; k < 2; ++k) dst[m][k] = *(const PG8_LAS bf16x8*)(lds + PG8_SA(b, h) + aoff + m * 2048 + k * 1024); } while (0)
#define PG8_LDB(dst, b, h) do { _Pragma("unroll") for (int n = 0; n < 2; ++n) _Pragma("unroll") for (int k = 0; k < 2; ++k) dst[n][k] = *(const PG8_LAS bf16x8*)(lds + PG8_SB(b, h) + boff + n * 2048 + k * 1024); } while (0)
#define PG8_MMA(ai, bj, At, Bt) do { __builtin_amdgcn_s_setprio(1); _Pragma("unroll") for (int m = 0; m < 4; ++m) _Pragma("unroll") for (int n = 0; n < 2; ++n) _Pragma("unroll") for (int k = 0; k < 2; ++k) \
        acc[ai][bj][m][n] = __builtin_amdgcn_mfma_f32_16x16x32_bf16(Bt[n][k], At[m][k], acc[ai][bj][m][n], 0, 0, 0); __builtin_amdgcn_s_setprio(0); } while (0)
#define PG8_WAIT_V(n) asm volatile("s_waitcnt vmcnt(" #n ")" ::: "memory")
#define PG8_WAIT_L(n) asm volatile("s_waitcnt lgkmcnt(" #n ")" ::: "memory")
#define PG8_BAR __builtin_amdgcn_s_barrier()
#define PG8_SCHED __builtin_amdgcn_sched_barrier(0)
    Unit cur, nxt; int ui = 0;
    if (!S.next(0, cur)) return;
    f32x4 acc[2][2][4][2];
#pragma unroll
    for (int a = 0; a < 2; ++a)
#pragma unroll
        for (int b = 0; b < 2; ++b)
#pragma unroll
            for (int m = 0; m < 4; ++m)
#pragma unroll
                for (int n = 0; n < 2; ++n) acc[a][b][m][n] = (f32x4){0.f, 0.f, 0.f, 0.f};
    bf16x8 At[4][2], B0[2][2], B1[2][2];
    const char* cA = (const char*)g.A + (size_t)cur.pm * tstepA; const char* cB = (const char*)g.Bt + (size_t)cur.pn * tstep;
    S.a_ready(cur);
    PG8_STAGE(PG8_SB(0, 0), cB, voffB); PG8_STAGE(PG8_SA(0, 0), cA, voffA); PG8_STAGE(PG8_SB(0, 1), cB + hstep, voffB); PG8_STAGE(PG8_SA(0, 1), cA + hstepA, voffA);
    if (wr == 1) PG8_BAR;
    PG8_WAIT_V(4); PG8_BAR;
    PG8_STAGE(PG8_SB(1, 0), cB + kstep, voffB); PG8_STAGE(PG8_SA(1, 0), cA + kstep, voffA); PG8_STAGE(PG8_SB(1, 1), cB + hstep + kstep, voffB);
    PG8_WAIT_V(6); PG8_BAR;
    PG8_STAMP();
    for (;;) {
        const bool has_next = S.next(ui + 1, nxt);
        const char* nA = has_next ? (const char*)g.A + (size_t)nxt.pm * tstepA : cA; const char* nB = has_next ? (const char*)g.Bt + (size_t)nxt.pn * tstep : cB;
        for (int t = 0; t < nt; t += 2) {
            const bool last = (t == nt - 2);
            const char* a1 = cA + (size_t)(t + 1) * kstep;
            const char* a2 = last ? nA : cA + (size_t)(t + 2) * kstep; const char* b2 = last ? nB : cB + (size_t)(t + 2) * kstep;
            const char* a3 = a2 + kstep; const char* b3 = b2 + kstep;
            if (last && has_next) S.a_ready(nxt);
            PG8_LDB(B0, 0, 0); PG8_SCHED; PG8_LDA(At, 0, 0); PG8_STAGE(PG8_SA(1, 1), a1 + hstepA, voffA);
            PG8_WAIT_L(8); PG8_BAR; PG8_WAIT_L(0); PG8_MMA(0, 0, At, B0); PG8_BAR; PG8_SCHED;
            PG8_LDB(B1, 0, 1); PG8_STAGE(PG8_SB(0, 0), b2, voffB);
            PG8_BAR; PG8_WAIT_L(0); PG8_MMA(0, 1, At, B1); PG8_BAR;
            PG8_LDA(At, 0, 1); PG8_STAGE(PG8_SA(0, 0), a2, voffA);
            PG8_BAR; PG8_WAIT_L(0); PG8_MMA(1, 0, At, B0); PG8_BAR; PG8_SCHED;
            PG8_STAGE(PG8_SB(0, 1), b2 + hstep, voffB);
            PG8_WAIT_V(6); PG8_BAR; PG8_MMA(1, 1, At, B1); PG8_BAR;
            PG8_LDB(B0, 1, 0); PG8_SCHED; PG8_LDA(At, 1, 0); PG8_STAGE(PG8_SA(0, 1), a2 + hstepA, voffA);
            PG8_WAIT_L(8); PG8_BAR; PG8_WAIT_L(0); PG8_MMA(0, 0, At, B0); PG8_BAR; PG8_SCHED;
            PG8_LDB(B1, 1, 1); PG8_STAGE(PG8_SB(1, 0), b3, voffB);
            PG8_BAR; PG8_WAIT_L(0); PG8_MMA(0, 1, At, B1); PG8_BAR;
            PG8_LDA(At, 1, 1); PG8_STAGE(PG8_SA(1, 0), a3, voffA);
            PG8_BAR; PG8_WAIT_L(0); PG8_MMA(1, 0, At, B0); PG8_BAR; PG8_SCHED;
            PG8_STAGE(PG8_SB(1, 1), b3 + hstep, voffB);
            PG8_WAIT_V(6); PG8_BAR; PG8_MMA(1, 1, At, B1); PG8_BAR;
        }
        PG8_STAMP();
        if constexpr (!Epi::AFTER_DRAIN) { E(acc, cur, wr, wc, fr, fq); S.done(cur); }
        PG8_STAMP();
        if (!has_next) break;
#pragma unroll
        for (int a = 0; a < 2; ++a)
#pragma unroll
            for (int b = 0; b < 2; ++b)
#pragma unroll
                for (int m = 0; m < 4; ++m)
#pragma unroll
                    for (int n = 0; n < 2; ++n) acc[a][b][m][n] = (f32x4){0.f, 0.f, 0.f, 0.f};
        cur = nxt; cA = nA; cB = nB; ++ui;
    }
    PG8_WAIT_V(0);
    if (wr == 0) PG8_BAR;
    PG8_BAR;
    if constexpr (Epi::AFTER_DRAIN) { E.fused(acc, cur, wr, wc, fr, fq, lds, wid, lane); S.done(cur); }
    PG8_STAMP();
    if (STAMP && wid == 0) { stamps[lane] = lane < nts ? (((unsigned long long)(unsigned)ts_hi << 32) | (unsigned)ts_lo) : 0ull;
        if (lane == 62) stamps[62] = rt_entry; if (lane == 63) stamps[63] = (unsigned long long)wall_clock64(); }
#undef PG8_STAMP
#undef PG8_SA
#undef PG8_SB
#undef PG8_STAGE
#undef PG8_LDA
#undef PG8_LDB
#undef PG8_MMA
#undef PG8_WAIT_V
#undef PG8_WAIT_L
#undef PG8_BAR
#undef PG8_SCHED
}
}
namespace pg8 {
struct EpiResid {
    static constexpr bool PERM = false, AFTER_DRAIN = false;
    const float* base; float* out; int ldc; float alpha;
    __device__ __forceinline__ void operator()(const f32x4 (&acc)[2][2][4][2], const Unit& u, int wr, int wc, int fr, int fq) const {
        const int row0 = u.pm * BM + wr * 64 + fr, col0 = u.pn * BM + wc * 32 + 4 * fq;
#pragma unroll
        for (int ai = 0; ai < 2; ++ai)
#pragma unroll
            for (int m = 0; m < 4; ++m) { const size_t off = (size_t)(row0 + ai * HALF + m * 16) * ldc + col0;
                f32x4 bs[2][2];
#pragma unroll
                for (int bj = 0; bj < 2; ++bj)
#pragma unroll
                    for (int n = 0; n < 2; ++n) bs[bj][n] = *(const f32x4*)(base + off + bj * HALF + n * 16);
#pragma unroll
                for (int bj = 0; bj < 2; ++bj)
#pragma unroll
                    for (int n = 0; n < 2; ++n) *(f32x4*)(out + off + bj * HALF + n * 16) = bs[bj][n] * alpha + acc[ai][bj][m][n];
                asm volatile("" ::: "memory"); }
    }
};
}

#define LAS __attribute__((address_space(3)))
typedef unsigned short bf16;
typedef float f32x4 __attribute__((ext_vector_type(4)));
typedef float f32x16 __attribute__((ext_vector_type(16)));
typedef short bf16x8 __attribute__((ext_vector_type(8)));
typedef short s16x4 __attribute__((ext_vector_type(4)));
typedef unsigned u32x4 __attribute__((ext_vector_type(4)));
typedef unsigned u32x2 __attribute__((ext_vector_type(2)));
#define MFMA32(a, b, c) __builtin_amdgcn_mfma_f32_32x32x16_bf16(a, b, c, 0, 0, 0)
#define LDS_WAIT() asm volatile("s_waitcnt lgkmcnt(0)" ::: "memory")

constexpr int D_MODEL = 1024, BATCH = 32, SEQ = 2048, DEPTH = 2, M_TOK = BATCH * SEQ;
constexpr int IN_COLS = 3456, IN_PAD = 3584, D_FF = 2816, UP_COLS = 2 * D_FF;
constexpr int C_RQ = 0, C_RK = 384, C_RV = 768, C_RG = 1152, C_MQ = 1536, C_MK = 1920, C_MV = 2304, C_CB = 2688, C_CC = 2944, C_CH = 3200;
constexpr int CAT_RET = 0, CAT_MOBA = 384, CAT_CONV = 768;
constexpr float DN_ALPHA = 1.4142135623730951f, LN_EPS = 1e-5f, LOG2E = 1.4426950408889634f;
constexpr int NWAVES = 8, NTHR = 512;
constexpr size_t MiB = 1u << 20;
constexpr size_t WS_CTL = 0, CTL_BYTES = 4096;
constexpr size_t WS_ROPE = 1 * MiB;
constexpr size_t WS_WIN = 2 * MiB, WS_WOUT = 16 * MiB, WS_WUP = 20 * MiB, WS_WDN = 42 * MiB;
constexpr size_t WS_XB = 64 * MiB;
constexpr size_t WS_BIG = 192 * MiB, WS_PROJ = WS_BIG, WS_CAT = WS_BIG + 448 * MiB, WS_U = WS_BIG, WS_END = 896 * MiB;
constexpr int LDS_MISC = 131072, LDS_BYTES = 147456;

__device__ __forceinline__ float bf2f(unsigned short b) { return __uint_as_float(((unsigned)b) << 16); }
__device__ __forceinline__ float bflo(unsigned w) { return __uint_as_float(w << 16); }
__device__ __forceinline__ float bfhi(unsigned w) { return __uint_as_float(w & 0xffff0000u); }
__device__ __forceinline__ unsigned pk2(float lo, float hi) { unsigned r; asm volatile("v_cvt_pk_bf16_f32 %0, %1, %2" : "=v"(r) : "v"(lo), "v"(hi)); return r; }
__device__ __forceinline__ int crow(int r, int hi) { return (r & 3) + 8 * (r >> 2) + 4 * hi; }
__device__ __forceinline__ s16x4 vtr(const LAS char* p) { typedef short v4i16_t __attribute__((ext_vector_type(4))); return __builtin_bit_cast(s16x4, __builtin_amdgcn_ds_read_tr16_b64_v4i16((LAS v4i16_t*)p)); }
__device__ __forceinline__ float swap32_f(float v) { return __shfl_xor(v, 32); }
__device__ __forceinline__ float wave_sum(float v) {
#pragma unroll
    for (int o = 1; o < 64; o <<= 1) v += __shfl_xor(v, o);
    return v; }

struct Ctx { LAS unsigned char* lds; int tid, lane, wave, G, bid; };

__device__ __forceinline__ void p0_transpose_item(const float* W, int K, int N, bf16* WT, LAS float* scr, int item, int lane) {
    const int nblk = N / 32, kb = item / nblk, nb = item % nblk, k0 = 64 * kb, n0 = 32 * nb;
#pragma unroll 8
    for (int i = 0; i < 32; ++i) { const int kk = 2 * i + (lane >> 5); scr[kk * 33 + (lane & 31)] = W[(size_t)(k0 + kk) * N + n0 + (lane & 31)]; }
    LDS_WAIT(); asm volatile("" ::: "memory");
    const int c = lane & 7;
#pragma unroll
    for (int j = 0; j < 4; ++j) { const int n = (lane >> 3) + 8 * j; const LAS float* s = scr + (8 * c) * 33 + n;
        u32x4 o; o.x = pk2(s[0 * 33], s[1 * 33]); o.y = pk2(s[2 * 33], s[3 * 33]); o.z = pk2(s[4 * 33], s[5 * 33]); o.w = pk2(s[6 * 33], s[7 * 33]);
        *(u32x4*)(WT + (size_t)(n0 + n) * K + k0 + 8 * c) = o; }
    LDS_WAIT(); asm volatile("" ::: "memory");
}
struct P0Args { const float *x, *w_in, *w_out, *w_up, *w_down; unsigned char* ws; };
__device__ __forceinline__ void p0_prologue(const Ctx& F, const P0Args& a) {
    LAS float* scr = (LAS float*)(F.lds + F.wave * 16384);
    const int gw = F.bid * NWAVES + F.wave, NGW = F.G * NWAVES;
    constexpr int I_IN = (1024 / 64) * (IN_COLS / 32), I_OUT = (1024 / 64) * (1024 / 32), I_UP = (1024 / 64) * (UP_COLS / 32), I_DN = (D_FF / 64) * (1024 / 32);
    constexpr int PER_L = I_IN + I_OUT + I_UP + I_DN, NITEMS = DEPTH * PER_L;
    for (int it = gw; it < NITEMS; it += NGW) {
        const int l = it / PER_L; int r = it % PER_L;
        if (r < I_IN) { p0_transpose_item(a.w_in + (size_t)l * 1024 * IN_COLS, 1024, IN_COLS, (bf16*)(a.ws + WS_WIN) + (size_t)l * IN_PAD * 1024, scr, r, F.lane); continue; } r -= I_IN;
        if (r < I_OUT) { p0_transpose_item(a.w_out + (size_t)l * 1024 * 1024, 1024, 1024, (bf16*)(a.ws + WS_WOUT) + (size_t)l * 1024 * 1024, scr, r, F.lane); continue; } r -= I_OUT;
        if (r < I_UP) { p0_transpose_item(a.w_up + (size_t)l * 1024 * UP_COLS, 1024, UP_COLS, (bf16*)(a.ws + WS_WUP) + (size_t)l * UP_COLS * 1024, scr, r, F.lane); continue; } r -= I_UP;
        p0_transpose_item(a.w_down + (size_t)l * D_FF * 1024, D_FF, 1024, (bf16*)(a.ws + WS_WDN) + (size_t)l * 1024 * D_FF, scr, r, F.lane);
    }
    const size_t gt = (size_t)F.bid * NTHR + F.tid, NGT = (size_t)F.G * NTHR;
    for (size_t i = gt; i < (size_t)DEPTH * (IN_PAD - IN_COLS) * 1024 / 8; i += NGT) { const size_t l = i / ((IN_PAD - IN_COLS) * 128), r = i % ((IN_PAD - IN_COLS) * 128);
        *(u32x4*)((bf16*)(a.ws + WS_WIN) + (l * IN_PAD + IN_COLS) * 1024 + r * 8) = (u32x4){0u, 0u, 0u, 0u}; }
    for (size_t i = gt; i < (size_t)SEQ * 32; i += NGT) { const int pos = (int)(i >> 5), k = (int)(i & 31);
        const float inv = powf(10000.0f, -(float)(2 * k) / 64.0f); const float ang = (float)pos * inv; float sn, cs; sincosf(ang, &sn, &cs);
        float* t = (float*)(a.ws + WS_ROPE) + (size_t)pos * 64; t[k] = cs; t[32 + k] = sn; }
    bf16* xb = (bf16*)(a.ws + WS_XB);
    for (size_t i = gt; i < (size_t)M_TOK * D_MODEL / 8; i += NGT) { const f32x4 v0 = *(const f32x4*)(a.x + i * 8), v1 = *(const f32x4*)(a.x + i * 8 + 4);
        *(u32x4*)(xb + i * 8) = (u32x4){pk2(v0[0], v0[1]), pk2(v0[2], v0[3]), pk2(v1[0], v1[1]), pk2(v1[2], v1[3])}; }
}

__device__ __forceinline__ void ln_phase(const Ctx& F, const float* Y, const float* g, const float* bta, float* XF, bf16* XB) {
    const int gw = F.bid * NWAVES + F.wave, NGW = F.G * NWAVES;
    f32x4 gg[4], bb[4];
#pragma unroll
    for (int j = 0; j < 4; ++j) { gg[j] = *(const f32x4*)(g + 256 * j + 4 * F.lane); bb[j] = *(const f32x4*)(bta + 256 * j + 4 * F.lane); }
    for (int m = gw; m < M_TOK; m += NGW) {
        const f32x4* xr = (const f32x4*)(Y + (size_t)m * D_MODEL) + F.lane;
        f32x4 v[4]; float s = 0.f;
#pragma unroll
        for (int j = 0; j < 4; ++j) { v[j] = xr[64 * j]; s += (v[j].x + v[j].y) + (v[j].z + v[j].w); }
        const float mean = wave_sum(s) * (1.f / D_MODEL); float s2 = 0.f;
#pragma unroll
        for (int j = 0; j < 4; ++j) { v[j] = v[j] - mean; s2 += (v[j].x * v[j].x + v[j].y * v[j].y) + (v[j].z * v[j].z + v[j].w * v[j].w); }
        const float rstd = 1.0f / sqrtf(wave_sum(s2) * (1.f / D_MODEL) + LN_EPS);
        f32x4* xo = (f32x4*)(XF + (size_t)m * D_MODEL) + F.lane;
#pragma unroll
        for (int j = 0; j < 4; ++j) { v[j] = v[j] * rstd * gg[j] + bb[j]; xo[64 * j] = v[j]; }
        if (XB) { u32x2* o8 = (u32x2*)(XB + (size_t)m * D_MODEL) + F.lane;
#pragma unroll
            for (int j = 0; j < 4; ++j) o8[64 * j] = (u32x2){pk2(v[j].x, v[j].y), pk2(v[j].z, v[j].w)}; }
    }
}

__device__ __forceinline__ void unpack8(const u32x4 w, float (&f)[8]) { f[0] = bflo(w.x); f[1] = bfhi(w.x); f[2] = bflo(w.y); f[3] = bfhi(w.y); f[4] = bflo(w.z); f[5] = bfhi(w.z); f[6] = bflo(w.w); f[7] = bfhi(w.w); }
__device__ __forceinline__ void ffn_gate_phase(const Ctx& F, bf16* U, const float* cw  ) {
    constexpr int NCH = D_FF / 8, RUN = 16, NRUN = M_TOK / RUN;
    const size_t gt = (size_t)F.bid * NTHR + F.tid, NGT = (size_t)F.G * NTHR;
    for (size_t idx = gt; idx < (size_t)NCH * NRUN; idx += NGT) {
        const int c = (int)(idx % NCH), run = (int)(idx / NCH); const int t0 = run * RUN;
        float w0[8], w1[8], w2[8];
        { const f32x4 a0 = *(const f32x4*)(cw + c * 8), a1 = *(const f32x4*)(cw + c * 8 + 4), b0 = *(const f32x4*)(cw + D_FF + c * 8), b1 = *(const f32x4*)(cw + D_FF + c * 8 + 4), c0 = *(const f32x4*)(cw + 2 * D_FF + c * 8), c1 = *(const f32x4*)(cw + 2 * D_FF + c * 8 + 4);
#pragma unroll
          for (int e = 0; e < 4; ++e) { w0[e] = a0[e]; w0[4 + e] = a1[e]; w1[e] = b0[e]; w1[4 + e] = b1[e]; w2[e] = c0[e]; w2[4 + e] = c1[e]; } }
        bf16* base = U + (size_t)t0 * UP_COLS + c * 8;
        float am2[8], am1[8];
        if ((t0 & (SEQ - 1)) == 0) {
#pragma unroll
            for (int e = 0; e < 8; ++e) { am2[e] = 0.f; am1[e] = 0.f; } }
        else { unpack8(*(const u32x4*)(base - 2 * (size_t)UP_COLS), am2); unpack8(*(const u32x4*)(base - (size_t)UP_COLS), am1); }
#pragma unroll 4
        for (int t = 0; t < RUN; ++t) {
            float a[8], b[8]; unpack8(*(const u32x4*)(base + (size_t)t * UP_COLS), a); unpack8(*(const u32x4*)(base + (size_t)t * UP_COLS + D_FF), b);
            float o[8];
#pragma unroll
            for (int e = 0; e < 8; e += 2) { pg8::f32x2 v; v.x = w0[e] * am2[e] + w1[e] * am1[e] + w2[e] * a[e]; v.y = w0[e + 1] * am2[e + 1] + w1[e + 1] * am1[e + 1] + w2[e + 1] * a[e + 1];
                const pg8::f32x2 gl = pg8::gelu_pk(v); o[e] = gl.x * b[e]; o[e + 1] = gl.y * b[e + 1]; }
            *(u32x4*)(base + (size_t)t * UP_COLS + D_FF) = (u32x4){pk2(o[0], o[1]), pk2(o[2], o[3]), pk2(o[4], o[5]), pk2(o[6], o[7])};
#pragma unroll
            for (int e = 0; e < 8; ++e) { am2[e] = am1[e]; am1[e] = a[e]; }
        }
    }
}
__device__ __forceinline__ void conv_unit(const Ctx& F, const bf16* PROJ, const float* cw  , bf16* CAT, int item) {
    const int c = F.tid & 31, tg = F.tid >> 5, t0 = item * 256 + tg * 16;
    float w0[8], w1[8], w2[8];
#pragma unroll
    for (int e = 0; e < 8; ++e) { w0[e] = cw[c * 8 + e]; w1[e] = cw[256 + c * 8 + e]; w2[e] = cw[512 + c * 8 + e]; }
    const bf16* base = PROJ + (size_t)t0 * IN_PAD + c * 8;
    float pm2[8], pm1[8];
    if ((t0 & (SEQ - 1)) == 0) {
#pragma unroll
        for (int e = 0; e < 8; ++e) { pm2[e] = 0.f; pm1[e] = 0.f; } }
    else { float a[8], b[8];
        unpack8(*(const u32x4*)(base - 2 * (size_t)IN_PAD + C_CC), a); unpack8(*(const u32x4*)(base - 2 * (size_t)IN_PAD + C_CH), b);
#pragma unroll
        for (int e = 0; e < 8; ++e) pm2[e] = a[e] * b[e];
        unpack8(*(const u32x4*)(base - (size_t)IN_PAD + C_CC), a); unpack8(*(const u32x4*)(base - (size_t)IN_PAD + C_CH), b);
#pragma unroll
        for (int e = 0; e < 8; ++e) pm1[e] = a[e] * b[e]; }
#pragma unroll 4
    for (int t = 0; t < 16; ++t) {
        float cb[8], cc[8], ch[8]; const bf16* row = base + (size_t)t * IN_PAD;
        unpack8(*(const u32x4*)(row + C_CB), cb); unpack8(*(const u32x4*)(row + C_CC), cc); unpack8(*(const u32x4*)(row + C_CH), ch);
        float o[8];
#pragma unroll
        for (int e = 0; e < 8; ++e) { const float p = cc[e] * ch[e]; o[e] = cb[e] * (w0[e] * pm2[e] + w1[e] * pm1[e] + w2[e] * p); pm2[e] = pm1[e]; pm1[e] = p; }
        *(u32x4*)(CAT + (size_t)(t0 + t) * D_MODEL + CAT_CONV + c * 8) = (u32x4){pk2(o[0], o[1]), pk2(o[2], o[3]), pk2(o[4], o[5]), pk2(o[6], o[7])};
    }
}

constexpr int MB_KT = 0, MB_VT = 8192, MB_KM = 16384, MB_TB = 18432, MB_RED = 20480, MB_UNI = 24576;
__device__ __forceinline__ int t5_bucket_dev(int n) {
    if (n < 16) return n;
    int bkt = 16;
    bkt += (n >= 19); bkt += (n >= 21); bkt += (n >= 24); bkt += (n >= 27); bkt += (n >= 31); bkt += (n >= 35); bkt += (n >= 40); bkt += (n >= 46);
    bkt += (n >= 52); bkt += (n >= 59); bkt += (n >= 67); bkt += (n >= 77); bkt += (n >= 87); bkt += (n >= 99); bkt += (n >= 113);
    return bkt; }
__device__ __forceinline__ void moba_unit(const Ctx& F, const bf16* PROJ, const float* rel_bias, bf16* CAT, int b, int h, int qb) {
    LAS unsigned char* lds = F.lds; const int tid = F.tid, lane = F.lane, wid = F.wave, r32 = lane & 31, hi = lane >> 5;
    LAS float* KM = (LAS float*)(lds + MB_KM); LAS float* TB = (LAS float*)(lds + MB_TB); LAS float* RED = (LAS float*)(lds + MB_RED); LAS unsigned* UNI = (LAS unsigned*)(lds + MB_UNI);
    const size_t rowb = (size_t)b * SEQ;
    const bf16* Kg = PROJ + rowb * IN_PAD + C_MK + h * 64; const bf16* Vg = PROJ + rowb * IN_PAD + C_MV + h * 64; const bf16* Qg = PROJ + rowb * IN_PAD + C_MQ + h * 64;
    constexpr float C2 = 0.125f * LOG2E;
    if (tid < 128) TB[tid] = rel_bias[t5_bucket_dev(tid) * 6 + h] * LOG2E;
    if (tid == 0) UNI[0] = 0u;
    for (int j = 0; j < qb; ++j) {
        const int c = tid & 7, g = tid >> 3; float s[8];
#pragma unroll
        for (int e = 0; e < 8; ++e) s[e] = 0.f;
#pragma unroll
        for (int rr = 0; rr < 4; ++rr) { float f[8]; unpack8(*(const u32x4*)(Kg + (size_t)(256 * j + g * 4 + rr) * IN_PAD + c * 8), f);
#pragma unroll
            for (int e = 0; e < 8; ++e) s[e] += f[e]; }
#pragma unroll
        for (int e = 0; e < 8; ++e) { s[e] += __shfl_xor(s[e], 8); s[e] += __shfl_xor(s[e], 16); s[e] += __shfl_xor(s[e], 32); }
        if (lane < 8) {
#pragma unroll
            for (int e = 0; e < 8; ++e) RED[wid * 64 + lane * 8 + e] = s[e]; }
        __syncthreads();
        if (tid < 64) { float t = 0.f;
#pragma unroll
            for (int w = 0; w < 8; ++w) t += RED[w * 64 + tid];
            KM[j * 64 + tid] = t * (1.0f / 256.0f); }
        __syncthreads();
    }
    __syncthreads();
    const int qrel = wid * 32 + r32;
    bf16x8 qr[4];
#pragma unroll
    for (int s = 0; s < 4; ++s) qr[s] = *(const bf16x8*)(Qg + (size_t)(256 * qb + qrel) * IN_PAD + 16 * s + 8 * hi);
    unsigned sel = 0u;
    if (qb <= 3) sel = (1u << qb) - 1u;
    else {
        float gt[7];
#pragma unroll
        for (int j = 0; j < 7; ++j) { float a = 0.f;
            if (j < qb) {
#pragma unroll
                for (int s = 0; s < 4; ++s)
#pragma unroll
                    for (int e = 0; e < 8; ++e) a += bf2f((unsigned short)qr[s][e]) * KM[j * 64 + 16 * s + 8 * hi + e];
            }
            a += swap32_f(a); gt[j] = (j < qb) ? a : -INFINITY; }
#pragma unroll
        for (int j = 0; j < 7; ++j) { int rank = 0;
#pragma unroll
            for (int i = 0; i < 7; ++i) if (i != j) rank += (gt[i] > gt[j] || (gt[i] == gt[j] && i < j)) ? 1 : 0;
            if (j < qb && rank < 3) sel |= 1u << j; }
    }
    { unsigned wm = 0u;
#pragma unroll
      for (int j = 0; j < 7; ++j) if (__any((sel >> j) & 1u)) wm |= 1u << j;
      if (lane == 0 && wm) atomicOr((unsigned*)UNI, wm); }
    __syncthreads();
    const unsigned uni = UNI[0];
    float mrun = -1e30f, lrun = 0.f; f32x16 o0 = f32x16{}, o1 = f32x16{};
    const LAS char* kp0 = (const LAS char*)lds + MB_KT + hi * 1024 + r32 * 16;
    const LAS char* vp0 = (const LAS char*)lds + MB_VT + ((lane >> 4) & 1) * 32 + (lane & 3) * 8 + (4 * hi + ((lane & 15) >> 2)) * 64;
    const int srow = tid >> 3, sc = tid & 7;
    for (int blk = 0; blk <= qb; ++blk) {
        const int j = (blk == 0) ? qb : blk - 1; const bool own = (blk == 0);
        if (!own && !((uni >> j) & 1u)) continue;
        for (int jt = 0; jt < 4; ++jt) {
            { const size_t grow = (size_t)(256 * j + 64 * jt + srow) * IN_PAD + sc * 8;
              const u32x4 kv = *(const u32x4*)(Kg + grow), vv = *(const u32x4*)(Vg + grow);
              *(LAS u32x4*)(lds + MB_KT + sc * 1024 + srow * 16) = kv;
              *(LAS u32x4*)(lds + MB_VT + (sc >> 2) * 4096 + srow * 64 + (sc & 3) * 16) = vv; }
            __syncthreads();
            const bool active = own ? (64 * jt <= wid * 32 + 31) : (__any((sel >> j) & 1u) != 0);
            if (active) {
                f32x16 p0 = f32x16{}, p1 = f32x16{};
#pragma unroll
                for (int s = 0; s < 4; ++s) { const bf16x8 k0 = *(const LAS bf16x8*)(kp0 + s * 2048), k1 = *(const LAS bf16x8*)(kp0 + s * 2048 + 512);
                    p0 = MFMA32(k0, qr[s], p0); p1 = MFMA32(k1, qr[s], p1); }
                const int dist0 = (own ? 0 : 256 * (qb - j)) + qrel - 64 * jt - 4 * hi;
                const bool lookup = own || (j == qb - 1 && (256 + 32 * wid - 64 * jt - 63 < 128));
                const bool lanesel = own || ((sel >> j) & 1u);
                const float tb127 = TB[127];
                float mx = -1e30f;
#pragma unroll
                for (int r = 0; r < 16; ++r) {
                    const int d0 = dist0 - (r & 3) - 8 * (r >> 2), d1 = d0 - 32;
                    float b0 = tb127, b1 = tb127;
                    if (lookup) { b0 = TB[min(max(d0, 0), 127)]; b1 = TB[min(max(d1, 0), 127)]; }
                    float s0 = p0[r] * C2 + b0, s1 = p1[r] * C2 + b1;
                    const bool ok0 = lanesel && (!own || d0 >= 0), ok1 = lanesel && (!own || d1 >= 0);
                    s0 = ok0 ? s0 : -1e30f; s1 = ok1 ? s1 : -1e30f;
                    p0[r] = s0; p1[r] = s1; mx = fmaxf(mx, fmaxf(s0, s1)); }
                mx = fmaxf(mx, swap32_f(mx));
                const float mnew = fmaxf(mrun, mx), alpha = __builtin_amdgcn_exp2f(mrun - mnew); mrun = mnew;
                float ps = 0.f;
#pragma unroll
                for (int r = 0; r < 16; ++r) { p0[r] = __builtin_amdgcn_exp2f(p0[r] - mnew); p1[r] = __builtin_amdgcn_exp2f(p1[r] - mnew); ps += p0[r] + p1[r]; }
                lrun = lrun * alpha + ps;
#pragma unroll
                for (int r = 0; r < 16; ++r) { o0[r] *= alpha; o1[r] *= alpha; }
                u32x4 pw[4];
                pw[0] = (u32x4){pk2(p0[0], p0[1]), pk2(p0[2], p0[3]), pk2(p0[4], p0[5]), pk2(p0[6], p0[7])};
                pw[1] = (u32x4){pk2(p0[8], p0[9]), pk2(p0[10], p0[11]), pk2(p0[12], p0[13]), pk2(p0[14], p0[15])};
                pw[2] = (u32x4){pk2(p1[0], p1[1]), pk2(p1[2], p1[3]), pk2(p1[4], p1[5]), pk2(p1[6], p1[7])};
                pw[3] = (u32x4){pk2(p1[8], p1[9]), pk2(p1[10], p1[11]), pk2(p1[12], p1[13]), pk2(p1[14], p1[15])};
#pragma unroll
                for (int s = 0; s < 4; ++s) {
                    const s16x4 a0 = vtr(vp0 + s * 1024), a1 = vtr(vp0 + s * 1024 + 512), c0 = vtr(vp0 + 4096 + s * 1024), c1 = vtr(vp0 + 4096 + s * 1024 + 512);
                    const bf16x8 vf0 = (bf16x8){a0[0], a0[1], a0[2], a0[3], a1[0], a1[1], a1[2], a1[3]}, vf1 = (bf16x8){c0[0], c0[1], c0[2], c0[3], c1[0], c1[1], c1[2], c1[3]};
                    const bf16x8 pf = __builtin_bit_cast(bf16x8, pw[s]);
                    o0 = MFMA32(vf0, pf, o0); o1 = MFMA32(vf1, pf, o1); }
            }
            __syncthreads();
        }
    }
    const float ltot = lrun + swap32_f(lrun), inv = 1.0f / ltot;
    bf16* orow = CAT + (rowb + 256 * qb + qrel) * D_MODEL + CAT_MOBA + h * 64;
#pragma unroll
    for (int g4 = 0; g4 < 4; ++g4) {
        *(u32x2*)(orow + 8 * g4 + 4 * hi) = (u32x2){pk2(o0[4 * g4] * inv, o0[4 * g4 + 1] * inv), pk2(o0[4 * g4 + 2] * inv, o0[4 * g4 + 3] * inv)};
        *(u32x2*)(orow + 32 + 8 * g4 + 4 * hi) = (u32x2){pk2(o1[4 * g4] * inv, o1[4 * g4 + 1] * inv), pk2(o1[4 * g4 + 2] * inv, o1[4 * g4 + 3] * inv)}; }
    __syncthreads();
}
constexpr int RT_Q = 0, RT_K = 16384, RT_KZ = 32768, RT_V = 49152, RT_G = 65536, RT_S = 83968, RT_ST = 93184;
__device__ __forceinline__ void ret_stage(const Ctx& F, const bf16* PROJ, const float* rope, size_t tok0, int pos0, int h, float lg) {
    LAS unsigned char* lds = F.lds; const int i = F.tid >> 2, p = F.tid & 3;
    const bf16* row = PROJ + (tok0 + i) * IN_PAD + h * 64;
    float q1[8], q2[8], k1[8], k2[8];
    unpack8(*(const u32x4*)(row + C_RQ + 8 * p), q1); unpack8(*(const u32x4*)(row + C_RQ + 32 + 8 * p), q2);
    unpack8(*(const u32x4*)(row + C_RK + 8 * p), k1); unpack8(*(const u32x4*)(row + C_RK + 32 + 8 * p), k2);
    const u32x4 v0 = *(const u32x4*)(row + C_RV + 16 * p), v1 = *(const u32x4*)(row + C_RV + 16 * p + 8);
    const u32x4 g0 = *(const u32x4*)(row + C_RG + 16 * p), g1 = *(const u32x4*)(row + C_RG + 16 * p + 8);
    const float* rt = rope + (size_t)(pos0 + i) * 64 + 8 * p;
    const f32x4 c0 = *(const f32x4*)rt, c1 = *(const f32x4*)(rt + 4), s0 = *(const f32x4*)(rt + 32), s1 = *(const f32x4*)(rt + 36);
    const float zeta = __builtin_amdgcn_exp2f((float)(127 - i) * lg);
    float qa[8], qb[8], ka[8], kb[8], za[8], zb[8];
#pragma unroll
    for (int e = 0; e < 8; ++e) { const float c = e < 4 ? c0[e & 3] : c1[e & 3], s = e < 4 ? s0[e & 3] : s1[e & 3];
        qa[e] = q1[e] * c - q2[e] * s; qb[e] = q1[e] * s + q2[e] * c;
        ka[e] = (k1[e] * c - k2[e] * s) * 0.125f; kb[e] = (k1[e] * s + k2[e] * c) * 0.125f; za[e] = ka[e] * zeta; zb[e] = kb[e] * zeta; }
#define PK8(x) (u32x4){pk2(x[0], x[1]), pk2(x[2], x[3]), pk2(x[4], x[5]), pk2(x[6], x[7])}
    *(LAS u32x4*)(lds + RT_Q + p * 2048 + i * 16) = PK8(qa); *(LAS u32x4*)(lds + RT_Q + (4 + p) * 2048 + i * 16) = PK8(qb);
    *(LAS u32x4*)(lds + RT_K + p * 2048 + i * 16) = PK8(ka); *(LAS u32x4*)(lds + RT_K + (4 + p) * 2048 + i * 16) = PK8(kb);
    *(LAS u32x4*)(lds + RT_KZ + i * 64 + p * 16) = PK8(za); *(LAS u32x4*)(lds + RT_KZ + 8192 + i * 64 + p * 16) = PK8(zb);
#undef PK8
    *(LAS u32x4*)(lds + RT_V + (p >> 1) * 8192 + i * 64 + (p & 1) * 32) = v0; *(LAS u32x4*)(lds + RT_V + (p >> 1) * 8192 + i * 64 + (p & 1) * 32 + 16) = v1;
    *(LAS u32x4*)(lds + RT_G + i * 144 + p * 32) = g0; *(LAS u32x4*)(lds + RT_G + i * 144 + p * 32 + 16) = g1;
}
__device__ __forceinline__ bf16x8 tr_frag(const LAS char* p) { const s16x4 a = vtr(p), b = vtr(p + 512); return (bf16x8){a[0], a[1], a[2], a[3], b[0], b[1], b[2], b[3]}; }
__device__ __forceinline__ void ret_unit(const Ctx& F, const bf16* PROJ, const float* rope, bf16* CAT, int b, int h) {
    LAS unsigned char* lds = F.lds; const int tid = F.tid, lane = F.lane, wid = F.wave, r32 = lane & 31, hi = lane >> 5;
    const int ib = wid & 3, vh = wid >> 2, iloc = 32 * ib + r32;
    const float gam = 1.0f - __builtin_amdgcn_exp2f(-5.0f - (float)h), lg = log2f(gam), g128 = __builtin_amdgcn_exp2f(128.0f * lg);
    const float xi = __builtin_amdgcn_exp2f((float)(iloc + 1) * lg);
    const size_t rowb = (size_t)b * SEQ;
    f32x16 Sacc = f32x16{};
    for (int u = tid; u < 9216 / 4; u += NTHR) ((LAS unsigned*)(lds + RT_S))[u] = 0u;
    ret_stage(F, PROJ, rope, rowb, 0, h, lg);
    __syncthreads();
    const LAS char* trb = (const LAS char*)lds + (4 * hi + ((lane & 15) >> 2)) * 64 + ((lane >> 4) & 1) * 32 + (lane & 3) * 8;
    for (int c = 0; c < 16; ++c) {
        bf16x8 qf[4];
#pragma unroll
        for (int s = 0; s < 4; ++s) qf[s] = *(const LAS bf16x8*)(lds + RT_Q + (2 * s + hi) * 2048 + iloc * 16);
        f32x16 cross = f32x16{};
#pragma unroll
        for (int s = 0; s < 4; ++s) { const bf16x8 sf = *(const LAS bf16x8*)(lds + RT_S + (32 * vh + r32) * 144 + (16 * s + 8 * hi) * 2); cross = MFMA32(sf, qf[s], cross); }
        f32x16 inner = f32x16{};
        for (int jb = 0; jb <= ib; ++jb) {
            f32x16 sc = f32x16{};
#pragma unroll
            for (int s = 0; s < 4; ++s) { const bf16x8 kf = *(const LAS bf16x8*)(lds + RT_K + (2 * s + hi) * 2048 + (32 * jb + r32) * 16); sc = MFMA32(kf, qf[s], sc); }
            const int dd0 = iloc - 32 * jb - 4 * hi;
#pragma unroll
            for (int r = 0; r < 16; ++r) { const int dd = dd0 - (r & 3) - 8 * (r >> 2); const float w = __builtin_amdgcn_exp2f((float)dd * lg); sc[r] = dd >= 0 ? sc[r] * w : 0.f; }
            const u32x4 pw0 = (u32x4){pk2(sc[0], sc[1]), pk2(sc[2], sc[3]), pk2(sc[4], sc[5]), pk2(sc[6], sc[7])};
            const u32x4 pw1 = (u32x4){pk2(sc[8], sc[9]), pk2(sc[10], sc[11]), pk2(sc[12], sc[13]), pk2(sc[14], sc[15])};
            const bf16x8 vf0 = tr_frag(trb + RT_V + vh * 8192 + (32 * jb) * 64), vf1 = tr_frag(trb + RT_V + vh * 8192 + (32 * jb + 16) * 64);
            inner = MFMA32(vf0, __builtin_bit_cast(bf16x8, pw0), inner); inner = MFMA32(vf1, __builtin_bit_cast(bf16x8, pw1), inner);
        }
        float s1 = 0.f, s2 = 0.f;
#pragma unroll
        for (int r = 0; r < 16; ++r) { inner[r] += xi * cross[r]; s1 += inner[r]; s2 += inner[r] * inner[r]; }
        s1 += swap32_f(s1); s2 += swap32_f(s2);
        if (hi == 0) { ((LAS float*)(lds + RT_ST))[(vh * 128 + iloc) * 2] = s1; ((LAS float*)(lds + RT_ST))[(vh * 128 + iloc) * 2 + 1] = s2; }
        u32x2 gv[4];
#pragma unroll
        for (int g4 = 0; g4 < 4; ++g4) gv[g4] = *(const LAS u32x2*)(lds + RT_G + iloc * 144 + (32 * vh + 8 * g4 + 4 * hi) * 2);
        if (wid < 4) { const int dh = wid & 1, vs = wid >> 1;
#pragma unroll
            for (int r = 0; r < 16; ++r) Sacc[r] *= g128;
#pragma unroll
            for (int s = 0; s < 8; ++s) { const bf16x8 af = tr_frag(trb + RT_KZ + dh * 8192 + (16 * s) * 64), bfr = tr_frag(trb + RT_V + vs * 8192 + (16 * s) * 64); Sacc = MFMA32(af, bfr, Sacc); } }
        __syncthreads();
        { const float o1 = ((LAS float*)(lds + RT_ST))[((vh ^ 1) * 128 + iloc) * 2], o2 = ((LAS float*)(lds + RT_ST))[((vh ^ 1) * 128 + iloc) * 2 + 1];
          const float mean = (s1 + o1) * (1.0f / 64.0f), var = (s2 + o2) * (1.0f / 64.0f) - mean * mean, rstd = 1.0f / sqrtf(fmaxf(var, 0.f) + LN_EPS);
          bf16* orow = CAT + (rowb + 128 * c + iloc) * D_MODEL + CAT_RET + h * 64 + 32 * vh;
#pragma unroll
          for (int g4 = 0; g4 < 4; ++g4) { float y[4]; const float gg[4] = {bflo(gv[g4].x), bfhi(gv[g4].x), bflo(gv[g4].y), bfhi(gv[g4].y)};
#pragma unroll
              for (int e = 0; e < 4; ++e) { const float sl = gg[e] / (1.0f + __builtin_amdgcn_exp2f(-gg[e] * LOG2E)); y[e] = (inner[4 * g4 + e] - mean) * rstd * sl; }
              *(u32x2*)(orow + 8 * g4 + 4 * hi) = (u32x2){pk2(y[0], y[1]), pk2(y[2], y[3])}; } }
        if (wid < 4) { const int dh = wid & 1, vs = wid >> 1;
#pragma unroll
            for (int g4 = 0; g4 < 4; ++g4) *(LAS u32x2*)(lds + RT_S + (32 * vs + r32) * 144 + (32 * dh + 8 * g4 + 4 * hi) * 2) = (u32x2){pk2(Sacc[4 * g4], Sacc[4 * g4 + 1]), pk2(Sacc[4 * g4 + 2], Sacc[4 * g4 + 3])}; }
        if (c < 15) ret_stage(F, PROJ, rope, rowb + 128 * (c + 1), 128 * (c + 1), h, lg);
        __syncthreads();
    }
}
struct Args {
    const float *x, *w_in, *conv_w, *w_out, *ln1_g, *ln1_b, *w_up, *ffn_conv_w, *w_down, *ln2_g, *ln2_b, *rel_bias;
    float* out; unsigned char* ws; int ph_lo, ph_hi;
};
constexpr int N_RET = BATCH * 6, N_MOBA = BATCH * 6 * 8, N_CONV = M_TOK / 256, N_MIX = N_RET + N_MOBA + N_CONV;
constexpr int N_PHASES = 1 + 8 * DEPTH;

__global__ void __launch_bounds__(NTHR, 2) mega_fwd(Args args) {
    extern __shared__ __attribute__((aligned(16))) unsigned char lds_raw[];
    Ctx F0; F0.lds = (LAS unsigned char*)lds_raw; F0.tid = threadIdx.x; F0.lane = F0.tid & 63; F0.wave = 0; F0.G = gridDim.x; F0.bid = blockIdx.x;
    unsigned char* ws = args.ws;
    unsigned* ctl = (unsigned*)(ws + WS_CTL);
    bf16* XB = (bf16*)(ws + WS_XB); bf16* PROJ = (bf16*)(ws + WS_PROJ); bf16* CAT = (bf16*)(ws + WS_CAT); bf16* U = (bf16*)(ws + WS_U);
    const float* rope = (const float*)(ws + WS_ROPE);
    const int lo = args.ph_lo, hi = args.ph_hi;
    const bool coop = (hi - lo) > 1;
#define IN(k) (lo <= (k) && (k) < hi)
#ifndef EN_MASK
#define EN_MASK 0xffff
#endif
#define EN(k) ((EN_MASK >> (k)) & 1)
#define SEAM(k) do { if (IN(k) && IN((k) + 1)) { cg::this_grid().sync(); } } while (0)
#pragma nounroll
    for (int ph = lo; ph < hi; ++ph) {
        const int l = (ph - 1) >> 3, k = (ph - 1) & 7;
        Ctx F = F0; { int t_ = F0.tid; asm volatile("" : "+v"(t_)); F.tid = t_; F.lane = t_ & 63; F.wave = __builtin_amdgcn_readfirstlane(t_ >> 6); }
        if (ph == 0) { if (EN(0)) { P0Args pa{args.x, args.w_in, args.w_out, args.w_up, args.w_down, ws}; p0_prologue(F, pa); __syncthreads(); } }
        else if (k == 0 || k == 4) {
            if (EN(1)) {
            const bool up = (k == 4); const int N = up ? UP_COLS : IN_PAD;
            const bf16* Bt = up ? (const bf16*)(ws + WS_WUP) + (size_t)l * UP_COLS * 1024 : (const bf16*)(ws + WS_WIN) + (size_t)l * IN_PAD * 1024;
            pg8::Gemm g{XB, Bt, M_TOK, N, 1024, 1024}; pg8::StaticOrder S; S.init(M_TOK, N, F.G, F.bid);
            pg8::EpiBf16<0> E{up ? U : PROJ, N, nullptr, 0, 0};
            pg8::gemm_phase<pg8::EpiBf16<0>, pg8::StaticOrder>(F.lds, g, S, E, nullptr, F.tid); }
        }
        else if (k == 2 || k == 6) {
            if (EN(3)) {
            const bool dn = (k == 6);
            const bf16* A = dn ? U + D_FF : CAT; const int K = dn ? D_FF : 1024, lda = dn ? UP_COLS : 1024;
            const bf16* Bt = dn ? (const bf16*)(ws + WS_WDN) + (size_t)l * 1024 * D_FF : (const bf16*)(ws + WS_WOUT) + (size_t)l * 1024 * 1024;
            pg8::Gemm g{A, Bt, M_TOK, 1024, K, lda}; pg8::StaticOrder S; S.init(M_TOK, 1024, F.G, F.bid);
            pg8::EpiResid E{(ph == 3) ? args.x : (const float*)args.out, args.out, 1024, DN_ALPHA};
            pg8::gemm_phase<pg8::EpiResid, pg8::StaticOrder>(F.lds, g, S, E, nullptr, F.tid); }
        }
        else if (k == 1) {
            if (EN(2)) {
            LAS int* slot = (LAS int*)(F.lds + LDS_MISC);
            for (;;) {
                __syncthreads();
                if (F.tid == 0) slot[0] = (int)atomicAdd(ctl + 64 * (1 + l), 1u);
                __syncthreads();
                const int item = slot[0];
                if (item >= N_MIX) break;
                if (item < N_RET) { if (EN(9)) ret_unit(F, PROJ, rope, CAT, item / 6, item % 6); }
                else if (item < N_RET + N_MOBA) { if (EN(10)) { const int kk = item - N_RET; const int qb = 7 - kk / (BATCH * 6), bh = kk % (BATCH * 6); moba_unit(F, PROJ, args.rel_bias, CAT, bh / 6, bh % 6, qb); } }
                else conv_unit(F, PROJ, args.conv_w + (size_t)l * 3 * 256, CAT, item - N_RET - N_MOBA);
            } }
        }
        else if (k == 3 || k == 7) {
            if (EN(4)) {
            const bool second = (k == 7);
            ln_phase(F, args.out, (second ? args.ln2_g : args.ln1_g) + l * 1024, (second ? args.ln2_b : args.ln1_b) + l * 1024, args.out, (second && l + 1 >= DEPTH) ? nullptr : XB); }
        }
        else { if (EN(6)) ffn_gate_phase(F, U, args.ffn_conv_w + (size_t)l * 3 * D_FF); }
        if (ph + 1 < hi) cg::this_grid().sync();
    }
    (void)coop;
#undef IN
#undef SEAM
}

#ifndef MK_PER_PHASE
#define MK_PER_PHASE 0
#endif
extern "C" void kernel_launch(void* const* d_in, const int* in_sizes, int n_in, void* d_out, int out_size, void* d_ws, size_t ws_size, hipStream_t stream) {
    static int grid = 0;
    if (grid == 0) {
        if (n_in != 12 || in_sizes[0] != M_TOK * D_MODEL || out_size != M_TOK * D_MODEL || ws_size < WS_END) { fprintf(stderr, "kernel_launch: unexpected shapes (n_in %d, ws %zu)\n", n_in, ws_size); grid = -1; return; }
        if (hipFuncSetAttribute((const void*)mega_fwd, hipFuncAttributeMaxDynamicSharedMemorySize, LDS_BYTES) != hipSuccess) { fprintf(stderr, "kernel_launch: hipFuncSetAttribute failed\n"); grid = -1; return; }
        int dev = 0, cus = 0, per_cu = 0; hipGetDevice(&dev); hipDeviceGetAttribute(&cus, hipDeviceAttributeMultiprocessorCount, dev);
        hipOccupancyMaxActiveBlocksPerMultiprocessor(&per_cu, (const void*)mega_fwd, NTHR, LDS_BYTES);
        if (per_cu < 1) { fprintf(stderr, "kernel_launch: occupancy query says %d blocks per CU\n", per_cu); }
        (void)hipGetLastError();
        grid = cus;
        if (grid != 256) fprintf(stderr, "kernel_launch: note: %d CUs\n", grid);
    }
    if (grid < 0) return;
    hipMemsetAsync((char*)d_ws + WS_CTL, 0, CTL_BYTES, stream);
    Args a{};
    a.x = (const float*)d_in[0]; a.w_in = (const float*)d_in[1]; a.conv_w = (const float*)d_in[2]; a.w_out = (const float*)d_in[3]; a.ln1_g = (const float*)d_in[4]; a.ln1_b = (const float*)d_in[5];
    a.w_up = (const float*)d_in[6]; a.ffn_conv_w = (const float*)d_in[7]; a.w_down = (const float*)d_in[8]; a.ln2_g = (const float*)d_in[9]; a.ln2_b = (const float*)d_in[10]; a.rel_bias = (const float*)d_in[11];
    a.out = (float*)d_out; a.ws = (unsigned char*)d_ws;
#if MK_PER_PHASE
    for (int p = 0; p < N_PHASES; ++p) { a.ph_lo = p; a.ph_hi = p + 1; hipLaunchKernelGGL(mega_fwd, dim3(grid), dim3(NTHR), LDS_BYTES, stream, a); }
#else
    a.ph_lo = 0; a.ph_hi = N_PHASES;
    void* kargs[] = {&a};
    hipError_t e = hipLaunchCooperativeKernel((const void*)mega_fwd, dim3(grid), dim3(NTHR), kargs, LDS_BYTES, stream);
    if (e != hipSuccess) fprintf(stderr, "kernel_launch: cooperative launch failed: %s (grid %d)\n", hipGetErrorString(e), grid);
#endif
}
```

```cpp
#include <hip/hip_runtime.h>
#include <hip/hip_cooperative_groups.h>
#include <cstdio>
#include <cstdint>
namespace cg = cooperative_groups;
#define DUP_ONLY 3
#define DUP_P -1
#define STAGGER_US 0
#define EXTRA_SYNCS 0
#define GEMM_SP2 true
#define GEMM_ALIGN true
namespace pg8 {
#define PG8_LAS __attribute__((address_space(3)))
typedef unsigned short bf16_t;
typedef short bf16x8 __attribute__((ext_vector_type(8)));
typedef float f32x4 __attribute__((ext_vector_type(4)));
typedef unsigned u32x4 __attribute__((ext_vector_type(4)));
constexpr int BM = 256, BK = 64, HALF = 128, HTB = HALF * BK * 2  , STAGE_BYTES = 8 * HTB, NXCD = 8, WGM = 8;

__host__ __device__ __forceinline__ int lds_byte(int r, int c) { const int st = (r >> 4) * 2 + (c >> 5), rr = r & 15, cc = c & 31, ob = rr * 64 + cc * 2; return st * 1024 + (ob ^ (((ob >> 9) & 1) << 5)); }
__host__ __device__ __forceinline__ void stage_rc(int b, int& R, int& C) { const int st = b / 1024, sb = b % 1024, swz = sb ^ (((sb >> 9) & 1) << 5); R = (st >> 1) * 16 + swz / 64; C = (st & 1) * 32 + (swz % 64) / 2; }
__host__ __device__ __forceinline__ int perm32(int rho) { const int n = rho >> 4, i = rho & 15; return 8 * (i >> 2) + 4 * n + (i & 3); }

#define PG8_ZERO_ACC(acc) do { _Pragma("unroll") for (int a_ = 0; a_ < 2; ++a_) _Pragma("unroll") for (int b_ = 0; b_ < 2; ++b_) _Pragma("unroll") for (int m_ = 0; m_ < 4; ++m_) _Pragma("unroll") for (int n_ = 0; n_ < 2; ++n_) acc[a_][b_][m_][n_] = (f32x4){0.f, 0.f, 0.f, 0.f}; } while (0)
struct Unit { int pm, pn; };
struct Gemm { const bf16_t* A; const bf16_t* Bt; int M, N, K, lda; };

struct StaticOrder {
    int nM, nN, nwg, G, c;
    __host__ __device__ void init(int M, int N, int G_, int c_) { nM = M / BM; nN = N / BM; nwg = nM * nN; G = G_; c = c_; }
    __host__ __device__ bool next(int i, Unit& u) const {
        const long L = (long)i * G + c; if (L >= nwg) return false;
        int wgid = (int)L; { const int q = nwg / NXCD, r = nwg % NXCD, xcd = wgid % NXCD, off = wgid / NXCD; wgid = (xcd < r ? xcd * (q + 1) : r * (q + 1) + (xcd - r) * q) + off; }
        const int nig = WGM * nN, gid = wgid / nig, fm = gid * WGM, gsz = (nM - fm) < WGM ? (nM - fm) : WGM;
        u.pm = fm + ((wgid % nig) % gsz); u.pn = (wgid % nig) / gsz; return true;
    }
    __device__ __forceinline__ void a_ready(const Unit&) const {}
    __device__ __forceinline__ void done(const Unit&) const {}
};
__device__ __forceinline__ unsigned cvt_pk_bf16(float lo, float hi) { unsigned r; asm volatile("v_cvt_pk_bf16_f32 %0, %1, %2" : "=v"(r) : "v"(lo), "v"(hi)); return r; }
typedef float f32x2 __attribute__((ext_vector_type(2)));
__device__ __forceinline__ f32x2 gelu_pk(f32x2 v) {
    const f32x2 av = __builtin_elementwise_abs(v), d = av * 0.2316418882f + 1.0f;
    f32x2 t; t.x = __builtin_amdgcn_rcpf(d.x); t.y = __builtin_amdgcn_rcpf(d.y);
    f32x2 q = t * 0.5307027145f + (-0.7265760135f); q = q * t + 0.7107068705f; q = q * t + (-0.142248368f); q = q * t + 0.127414796f; q = q * t;
    const f32x2 s = (v * v) * (-0.72134752044f);
    f32x2 e; e.x = __builtin_amdgcn_exp2f(s.x); e.y = __builtin_amdgcn_exp2f(s.y);
    const f32x2 m = v * (q * e), r = v - m;
    f32x2 o; o.x = v.x < 0.f ? m.x : r.x; o.y = v.y < 0.f ? m.y : r.y; return o;
}
__device__ __forceinline__ f32x2 gelu_mul_pk(f32x2 v, f32x2 b) {
    const f32x2 av = __builtin_elementwise_abs(v), d = av * 0.2316418882f + 1.0f;
    f32x2 t; t.x = __builtin_amdgcn_rcpf(d.x); t.y = __builtin_amdgcn_rcpf(d.y);
    f32x2 q = t * 0.5307027145f + (-0.7265760135f); q = q * t + 0.7107068705f; q = q * t + (-0.142248368f); q = q * t + 0.127414796f; q = q * t;
    const f32x2 s = (v * v) * (-0.72134752044f);
    f32x2 e; e.x = __builtin_amdgcn_exp2f(s.x); e.y = __builtin_amdgcn_exp2f(s.y);
    const f32x2 h = 0.5f - q * e;
    return (av * h + v * 0.5f) * b;
}
template <int ACT  > struct EpiBf16 {
    static constexpr bool PERM = true, AFTER_DRAIN = false, ROWPERM = false;
    __device__ __forceinline__ void init(f32x4 (&acc)[2][2][4][2], const Unit&, int, int, int, int) const { PG8_ZERO_ACC(acc); }
    bf16_t* O; int ldc; const float* bias; int split_cols; size_t split_stride;
    __device__ __forceinline__ void operator()(const f32x4 (&acc)[2][2][4][2], const Unit& u, int wr, int wc, int fr, int fq) const {
        const int row0 = u.pm * BM + wr * 64 + fr; int colt = u.pn * BM; bf16_t* base = O;
        if (split_cols) { const int t = colt / split_cols; base += (size_t)t * split_stride; colt -= t * split_cols; }
        const int col0 = colt + wc * 32 + 8 * fq, bcol0 = u.pn * BM + wc * 32 + 8 * fq;
        f32x4 bv[2][2];
#pragma unroll
        for (int bj = 0; bj < 2; ++bj)
#pragma unroll
            for (int n = 0; n < 2; ++n) bv[bj][n] = bias ? *(const f32x4*)(bias + bcol0 + bj * HALF + 4 * n) : (f32x4){0.f, 0.f, 0.f, 0.f};
#pragma unroll
        for (int ai = 0; ai < 2; ++ai)
#pragma unroll
            for (int m = 0; m < 4; ++m) { bf16_t* rowp = base + (size_t)(row0 + ai * HALF + m * 16) * ldc + col0;
#pragma unroll
                for (int bj = 0; bj < 2; ++bj) { f32x4 v0 = acc[ai][bj][m][0] + bv[bj][0], v1 = acc[ai][bj][m][1] + bv[bj][1];
                    if (ACT == 1) { f32x2 a = gelu_pk((f32x2){v0[0], v0[1]}), b = gelu_pk((f32x2){v0[2], v0[3]}), c = gelu_pk((f32x2){v1[0], v1[1]}), d = gelu_pk((f32x2){v1[2], v1[3]});
                        v0 = (f32x4){a.x, a.y, b.x, b.y}; v1 = (f32x4){c.x, c.y, d.x, d.y}; }
                    if (ACT == 2) {
#pragma unroll
                        for (int j = 0; j < 4; ++j) { v0[j] = 0.5f * v0[j] * (1.0f + erff(v0[j] * 0.70710678f)); v1[j] = 0.5f * v1[j] * (1.0f + erff(v1[j] * 0.70710678f)); } }
                    u32x4 w; w.x = cvt_pk_bf16(v0[0], v0[1]); w.y = cvt_pk_bf16(v0[2], v0[3]); w.z = cvt_pk_bf16(v1[0], v1[1]); w.w = cvt_pk_bf16(v1[2], v1[3]);
                    *(u32x4*)(rowp + bj * HALF) = w; } }
    }
};

template <class Epi, class Sched, bool ALIGN_EPI = false, bool SP2 = false>
__device__ __forceinline__ void gemm_phase(PG8_LAS unsigned char* lds, const Gemm g, const Sched& S, const Epi& E, const int tid) {
    const int wid = __builtin_amdgcn_readfirstlane(tid >> 6), lane = tid & 63, wr = wid >> 2, wc = wid & 3, fr = lane & 15, fq = lane >> 4;
    const int K = g.K, nt = K / BK;
    unsigned voffA[2], voffB[2];
#pragma unroll
    for (int i = 0; i < 2; ++i) { int R, C; stage_rc(tid * 16 + i * 8192, R, C); const int Rb = Epi::PERM ? ((R & ~31) + perm32(R & 31)) : R;
        const int Ra = Epi::ROWPERM ? (128 * (R >> 6) + 8 * (R & 15) + ((R >> 4) & 3)) : R; voffA[i] = (unsigned)(Ra * g.lda + C) * 2u; voffB[i] = (unsigned)(Rb * K + C) * 2u; }
    const size_t kstep = (size_t)(BK * 2);
    const size_t hstep = (size_t)HALF * K * 2; const size_t hstepA = (size_t)(Epi::ROWPERM ? 4 : HALF) * g.lda * 2; const size_t tstepA = (size_t)BM * g.lda * 2;
    const size_t tstep = 2 * hstep;
    const unsigned ldsw = (unsigned)wid * 1024u;
    const int aoff = lds_byte(wr * 64 + fr, fq * 8), boff = lds_byte(wc * 32 + fr, fq * 8);
#define PG8_SA(b, h) (((b) * 2 + (h)) * HTB)
#define PG8_SB(b, h) ((4 + (b) * 2 + (h)) * HTB)
#define PG8_STAGE(bufoff, gbase, voff) do { _Pragma("unroll") for (int _i = 0; _i < 2; ++_i) \
        __builtin_amdgcn_global_load_lds((const unsigned*)((const char*)(gbase) + (voff)[_i]), (PG8_LAS unsigned*)(lds + (bufoff) + ldsw + _i * 8192), 16, 0, 0); } while (0)
#define PG8_LDA(dst, b, h) do { _Pragma("unroll") for (int m = 0; m < 4; ++m) _Pragma("unroll") for (int k = 0; k < 2; ++k) dst[m][k] = *(const PG8_LAS bf16x8*)(lds + PG8_SA(b, h) + aoff + m * 2048 + k * 1024); } while (0)
#define PG8_LDB(dst, b, h) do { _Pragma("unroll") for (int n = 0; n < 2; ++n) _Pragma("unroll") for (int k = 0; k < 2; ++k) dst[n][k] = *(const PG8_LAS bf16x8*)(lds + PG8_SB(b, h) + boff + n * 2048 + k * 1024); } while (0)
#define PG8_MMA(ai, bj, At, Bt) do { __builtin_amdgcn_s_setprio(1); _Pragma("unroll") for (int m = 0; m < 4; ++m) _Pragma("unroll") for (int n = 0; n < 2; ++n) _Pragma("unroll") for (int k = 0; k < 2; ++k) \
        acc[ai][bj][m][n] = __builtin_amdgcn_mfma_f32_16x16x32_bf16(Bt[n][k], At[m][k], acc[ai][bj][m][n], 0, 0, 0); __builtin_amdgcn_s_setprio(0); } while (0)
#define PG8_WAIT_V(n) asm volatile("s_waitcnt vmcnt(" #n ")" ::: "memory")
#define PG8_WAIT_L(n) asm volatile("s_waitcnt lgkmcnt(" #n ")" ::: "memory")
#define PG8_BAR __builtin_amdgcn_s_barrier()
#define PG8_SCHED __builtin_amdgcn_sched_barrier(0)
    Unit cur, nxt; int ui = 0;
    if (!S.next(0, cur)) return;
    f32x4 acc[2][2][4][2];
    E.init(acc, cur, wr, wc, fr, fq);

    bf16x8 At[4][2], B0[2][2], B1[2][2];
    const char* cA = (const char*)g.A + (size_t)cur.pm * tstepA; const char* cB = (const char*)g.Bt + (size_t)cur.pn * tstep;
    S.a_ready(cur);
    if constexpr (SP2) {
        PG8_STAGE(PG8_SB(0, 0), cB, voffB); PG8_STAGE(PG8_SB(0, 1), cB + hstep, voffB); PG8_STAGE(PG8_SA(0, 0), cA, voffA); PG8_STAGE(PG8_SA(0, 1), cA + hstepA, voffA);
        if (wr == 1) PG8_BAR;
        PG8_WAIT_V(2); PG8_BAR;
        PG8_STAGE(PG8_SB(1, 0), cB + kstep, voffB); PG8_STAGE(PG8_SA(1, 0), cA + kstep, voffA); PG8_STAGE(PG8_SB(1, 1), cB + hstep + kstep, voffB);
        PG8_WAIT_V(6); PG8_BAR;
    } else {
        PG8_STAGE(PG8_SB(0, 0), cB, voffB); PG8_STAGE(PG8_SA(0, 0), cA, voffA); PG8_STAGE(PG8_SB(0, 1), cB + hstep, voffB); PG8_STAGE(PG8_SA(0, 1), cA + hstepA, voffA);
        if (wr == 1) PG8_BAR;
        PG8_WAIT_V(4); PG8_BAR;
        PG8_STAGE(PG8_SB(1, 0), cB + kstep, voffB); PG8_STAGE(PG8_SA(1, 0), cA + kstep, voffA); PG8_STAGE(PG8_SB(1, 1), cB + hstep + kstep, voffB);
        PG8_WAIT_V(6); PG8_BAR;
    }
    for (;;) {
        const bool has_next = S.next(ui + 1, nxt);
        const char* nA = has_next ? (const char*)g.A + (size_t)nxt.pm * tstepA : cA; const char* nB = has_next ? (const char*)g.Bt + (size_t)nxt.pn * tstep : cB;
        for (int t = 0; t < nt; t += 2) {
            const bool last = (t == nt - 2);
            const char* a1 = cA + (size_t)(t + 1) * kstep;
            const char* a2 = last ? nA : cA + (size_t)(t + 2) * kstep; const char* b2 = last ? nB : cB + (size_t)(t + 2) * kstep;
            const char* a3 = a2 + kstep; const char* b3 = b2 + kstep;
            if (last && has_next) S.a_ready(nxt);
            if constexpr (SP2) {
            PG8_LDB(B0, 0, 0); PG8_LDB(B1, 0, 1); PG8_SCHED; PG8_LDA(At, 0, 0); PG8_STAGE(PG8_SA(1, 1), a1 + hstepA, voffA);
            PG8_WAIT_V(8); PG8_WAIT_L(0); PG8_BAR; PG8_MMA(0, 0, At, B0); PG8_MMA(0, 1, At, B1); PG8_BAR; PG8_SCHED;
            PG8_LDA(At, 0, 1); PG8_STAGE(PG8_SB(0, 0), b2, voffB); PG8_STAGE(PG8_SB(0, 1), b2 + hstep, voffB); PG8_STAGE(PG8_SA(0, 0), a2, voffA);
            PG8_WAIT_V(8); PG8_WAIT_L(0); PG8_BAR; PG8_MMA(1, 0, At, B0); PG8_MMA(1, 1, At, B1); PG8_BAR; PG8_SCHED;
            PG8_LDB(B0, 1, 0); PG8_LDB(B1, 1, 1); PG8_SCHED; PG8_LDA(At, 1, 0); PG8_STAGE(PG8_SA(0, 1), a2 + hstepA, voffA);
            PG8_WAIT_V(8); PG8_WAIT_L(0); PG8_BAR; PG8_MMA(0, 0, At, B0); PG8_MMA(0, 1, At, B1); PG8_BAR; PG8_SCHED;
            PG8_LDA(At, 1, 1); PG8_STAGE(PG8_SB(1, 0), b3, voffB); PG8_STAGE(PG8_SB(1, 1), b3 + hstep, voffB); PG8_STAGE(PG8_SA(1, 0), a3, voffA);
            PG8_WAIT_V(8); PG8_WAIT_L(0); PG8_BAR; PG8_MMA(1, 0, At, B0); PG8_MMA(1, 1, At, B1); PG8_BAR; PG8_SCHED;
            } else {
            PG8_LDB(B0, 0, 0); PG8_SCHED; PG8_LDA(At, 0, 0); PG8_STAGE(PG8_SA(1, 1), a1 + hstepA, voffA);
            PG8_WAIT_L(8); PG8_BAR; PG8_WAIT_L(0); PG8_MMA(0, 0, At, B0); PG8_BAR; PG8_SCHED;
            PG8_LDB(B1, 0, 1); PG8_STAGE(PG8_SB(0, 0), b2, voffB);
            PG8_BAR; PG8_WAIT_L(0); PG8_MMA(0, 1, At, B1); PG8_BAR;
            PG8_LDA(At, 0, 1); PG8_STAGE(PG8_SA(0, 0), a2, voffA);
            PG8_BAR; PG8_WAIT_L(0); PG8_MMA(1, 0, At, B0); PG8_BAR; PG8_SCHED;
            PG8_STAGE(PG8_SB(0, 1), b2 + hstep, voffB);
            PG8_WAIT_V(6); PG8_BAR; PG8_MMA(1, 1, At, B1); PG8_BAR;
            PG8_LDB(B0, 1, 0); PG8_SCHED; PG8_LDA(At, 1, 0); PG8_STAGE(PG8_SA(0, 1), a2 + hstepA, voffA);
            PG8_WAIT_L(8); PG8_BAR; PG8_WAIT_L(0); PG8_MMA(0, 0, At, B0); PG8_BAR; PG8_SCHED;
            PG8_LDB(B1, 1, 1); PG8_STAGE(PG8_SB(1, 0), b3, voffB);
            PG8_BAR; PG8_WAIT_L(0); PG8_MMA(0, 1, At, B1); PG8_BAR;
            PG8_LDA(At, 1, 1); PG8_STAGE(PG8_SA(1, 0), a3, voffA);
            PG8_BAR; PG8_WAIT_L(0); PG8_MMA(1, 0, At, B0); PG8_BAR; PG8_SCHED;
            PG8_STAGE(PG8_SB(1, 1), b3 + hstep, voffB);
            PG8_WAIT_V(6); PG8_BAR; PG8_MMA(1, 1, At, B1); PG8_BAR;
            }
        }
        if constexpr (ALIGN_EPI) { if (wr == 0) PG8_BAR; }
        if constexpr (!Epi::AFTER_DRAIN) { E(acc, cur, wr, wc, fr, fq); S.done(cur); }
        if (!has_next) break;
        E.init(acc, nxt, wr, wc, fr, fq);
        cur = nxt; cA = nA; cB = nB; ++ui;
        if constexpr (ALIGN_EPI) { if (wr == 1) PG8_BAR; }
    }
    PG8_WAIT_V(0);
    if constexpr (!ALIGN_EPI) { if (wr == 0) PG8_BAR; }
    PG8_BAR;
    if constexpr (Epi::AFTER_DRAIN) { E.fused(acc, cur, wr, wc, fr, fq, lds, wid, lane); S.done(cur); }
#undef PG8_SA
#undef PG8_SB
#undef PG8_STAGE
#undef PG8_LDA
#undef PG8_LDB
#undef PG8_MMA
#undef PG8_WAIT_V
#undef PG8_WAIT_L
#undef PG8_BAR
#undef PG8_SCHED
}
}
namespace pg8 {
struct EpiProj {
    static constexpr bool PERM = true, AFTER_DRAIN = false, ROWPERM = false;
    __device__ __forceinline__ void init(f32x4 (&acc)[2][2][4][2], const Unit&, int, int, int, int) const { PG8_ZERO_ACC(acc); }
    int skip; bf16_t* O; int ldc; float* kms; int kc0, qc0; float qscale;
    __device__ __forceinline__ void operator()(const f32x4 (&acc)[2][2][4][2], const Unit& u, int wr, int wc, int fr, int fq) const {
        if (skip) { if (acc[0][0][0][0][0] == 123.456f) O[0] = 1; return; }
        const int row0 = u.pm * BM + wr * 64 + fr, col0 = u.pn * BM + wc * 32 + 8 * fq;
#pragma unroll
        for (int ai = 0; ai < 2; ++ai)
#pragma unroll
            for (int m = 0; m < 4; ++m) { bf16_t* rowp = O + (size_t)(row0 + ai * HALF + m * 16) * 64 + (size_t)(col0 >> 6) * ((size_t)65536 * 64) + (col0 & 63);
#pragma unroll
                for (int bj = 0; bj < 2; ++bj) { const int cq = col0 + bj * HALF - qc0; const float qs = (cq >= 0 && cq < 384) ? qscale : 1.0f;
                    const f32x4 v0 = acc[ai][bj][m][0] * qs, v1 = acc[ai][bj][m][1] * qs;
                    u32x4 w; w.x = cvt_pk_bf16(v0[0], v0[1]); w.y = cvt_pk_bf16(v0[2], v0[3]); w.z = cvt_pk_bf16(v1[0], v1[1]); w.w = cvt_pk_bf16(v1[2], v1[3]);
                    *(u32x4*)(rowp + (size_t)bj * 2 * ((size_t)65536 * 64)) = w; } }
#pragma unroll
        for (int bj = 0; bj < 2; ++bj) { const int c = col0 + bj * HALF - kc0;
            if (c >= 0 && c < 384) {
#pragma unroll
                for (int n = 0; n < 2; ++n) { f32x4 sv = (f32x4){0.f, 0.f, 0.f, 0.f};
#pragma unroll
                    for (int ai = 0; ai < 2; ++ai)
#pragma unroll
                        for (int m = 0; m < 4; ++m) sv += acc[ai][bj][m][n];
#pragma unroll
                    for (int e = 0; e < 4; ++e) { float t = sv[e]; t += __shfl_xor(t, 1); t += __shfl_xor(t, 2); t += __shfl_xor(t, 4); t += __shfl_xor(t, 8);
                        if (fr == 0) atomicAdd(kms + (size_t)u.pm * 384 + c + 4 * n + e, t); } } } }
    }
};
struct EpiGate {
    static constexpr bool PERM = true, AFTER_DRAIN = false, ROWPERM = true;
    __device__ __forceinline__ void init(f32x4 (&acc)[2][2][4][2], const Unit&, int, int, int, int) const { PG8_ZERO_ACC(acc); }
    bf16_t* G; int ldg; const float* cw; int ncol; float* last; float* fixs; float* fixb;
    __device__ __forceinline__ void operator()(const f32x4 (&acc)[2][2][4][2], const Unit& u, int wr, int wc, int fr, int fq) const {
        const int col = u.pn * HALF + wc * 32 + 8 * fq, hp = 2 * u.pm + wr;
        f32x4 w[3][2];
#pragma unroll
        for (int i = 0; i < 3; ++i) { w[i][0] = *(const f32x4*)(cw + i * ncol + col); w[i][1] = *(const f32x4*)(cw + i * ncol + col + 4); }
        f32x4 p6[2], p7[2];
#pragma unroll
        for (int n = 0; n < 2; ++n)
#pragma unroll
            for (int e = 0; e < 4; ++e) { p6[n][e] = __shfl_up(acc[1][0][2][n][e], 1); p7[n][e] = __shfl_up(acc[1][0][3][n][e], 1); }
        bf16_t* grow = G + (size_t)(u.pm * BM + 128 * wr + 8 * fr) * ldg + col;
#pragma unroll
        for (int j = 0; j < 8; ++j) {
            const int ai = j >> 2, m = j & 3;
            u32x4 o;
#pragma unroll
            for (int n = 0; n < 2; ++n) {
                f32x4 s = acc[ai][0][m][n] * w[2][n];
                if (j >= 1) s += acc[(j - 1) >> 2][0][(j - 1) & 3][n] * w[1][n]; else if (fr != 0) s += p7[n] * w[1][n];
                if (j >= 2) s += acc[(j - 2) >> 2][0][(j - 2) & 3][n] * w[0][n]; else if (fr != 0) s += (j == 0 ? p6[n] : p7[n]) * w[0][n];
                const f32x4 b = acc[ai][1][m][n];
                if (j < 2 && fr == 0) { *(f32x4*)(fixs + ((size_t)hp * 2 + j) * ncol + col + 4 * n) = s; *(f32x4*)(fixb + ((size_t)hp * 2 + j) * ncol + col + 4 * n) = b; }
                const f32x2 g0 = gelu_mul_pk((f32x2){s[0], s[1]}, (f32x2){b[0], b[1]}), g1 = gelu_mul_pk((f32x2){s[2], s[3]}, (f32x2){b[2], b[3]});
                const unsigned lo = cvt_pk_bf16(g0.x, g0.y), hi = cvt_pk_bf16(g1.x, g1.y);
                if (n == 0) { o.x = lo; o.y = hi; } else { o.z = lo; o.w = hi; }
                if (j >= 6 && fr == 15) *(f32x4*)(last + ((size_t)hp * 2 + (j - 6)) * ncol + col + 4 * n) = acc[ai][0][m][n];
            }
            if (!(j < 2 && fr == 0)) *(u32x4*)(grow + (size_t)j * ldg) = o;
        }
    }
};
}

#define LAS __attribute__((address_space(3)))
typedef unsigned short bf16;
typedef float f32x4 __attribute__((ext_vector_type(4)));
typedef float f32x16 __attribute__((ext_vector_type(16)));
typedef short bf16x8 __attribute__((ext_vector_type(8)));
typedef short s16x4 __attribute__((ext_vector_type(4)));
typedef unsigned u32x4 __attribute__((ext_vector_type(4)));
typedef unsigned u32x2 __attribute__((ext_vector_type(2)));
#define MFMA32(a, b, c) __builtin_amdgcn_mfma_f32_32x32x16_bf16(a, b, c, 0, 0, 0)
#define LDS_WAIT() asm volatile("s_waitcnt lgkmcnt(0)" ::: "memory")

constexpr int D_MODEL = 1024, BATCH = 32, SEQ = 2048, DEPTH = 2, M_TOK = BATCH * SEQ;
constexpr int PR = 64;
constexpr int IN_COLS = 3456, IN_PAD = 3584, D_FF = 2816, UP_COLS = 2 * D_FF;
constexpr int C_RQ = 0, C_RK = 384, C_RV = 768, C_RG = 1152, C_MQ = 1536, C_MK = 1920, C_MV = 2304, C_CB = 2688, C_CC = 2944, C_CH = 3200;
constexpr int CAT_RET = 0, CAT_MOBA = 384, CAT_CONV = 768;
constexpr float DN_ALPHA = 1.4142135623730951f, LN_EPS = 1e-5f, LOG2E = 1.4426950408889634f;
constexpr int NWAVES = 8, NTHR = 512;
constexpr size_t PG = (size_t)M_TOK * 64;
constexpr size_t MiB = 1u << 20;
constexpr size_t WS_CTL = 0, CTL_BYTES = 65536, WS_KMS = 65536, KMS_BYTES = 256 * 384 * 4;
constexpr size_t WS_ROPE = 1 * MiB; constexpr size_t WS_STATS = 1 * MiB + 512 * 1024;
constexpr size_t WS_WIN = 2 * MiB, WS_WOUT = 16 * MiB, WS_WUP = 20 * MiB, WS_WDN = 42 * MiB;
constexpr size_t WS_XB = 64 * MiB;
constexpr size_t WS_BIG = 192 * MiB, WS_PROJ = WS_BIG, WS_CAT = WS_BIG + 448 * MiB, WS_G = WS_BIG, WS_LAST = 768 * MiB, WS_FIXS = 780 * MiB, WS_FIXB = 792 * MiB, WS_YB = 804 * MiB, WS_END = 932 * MiB;
constexpr int LDS_MISC = 131072, LDS_BYTES = 147456;

__device__ __forceinline__ float bf2f(unsigned short b) { return __uint_as_float(((unsigned)b) << 16); }
__device__ __forceinline__ float bflo(unsigned w) { return __uint_as_float(w << 16); }
__device__ __forceinline__ float bfhi(unsigned w) { return __uint_as_float(w & 0xffff0000u); }
__device__ __forceinline__ unsigned pk2(float lo, float hi) { unsigned r; asm volatile("v_cvt_pk_bf16_f32 %0, %1, %2" : "=v"(r) : "v"(lo), "v"(hi)); return r; }
__device__ __forceinline__ int crow(int r, int hi) { return (r & 3) + 8 * (r >> 2) + 4 * hi; }
__device__ __forceinline__ s16x4 vtr(const LAS char* p) { typedef short v4i16_t __attribute__((ext_vector_type(4))); return __builtin_bit_cast(s16x4, __builtin_amdgcn_ds_read_tr16_b64_v4i16((LAS v4i16_t*)p)); }
__device__ __forceinline__ float swap32_f(float v) { return __shfl_xor(v, 32); }
__device__ __forceinline__ float wave_sum(float v) {
#pragma unroll
    for (int o = 1; o < 64; o <<= 1) v += __shfl_xor(v, o);
    return v; }

constexpr int CW_BAR = 4096;
#define XB_TMO      128
#define XB_XCNT(j)  (256  + 64 * (j))
#define XB_XSUB(j)  (1280 + 64 * (j))
#define XB_XGEN(j)  (2304 + 64 * (j))
#define XB_TOP      3328
#define XB_TOPGEN   3392
#define XCD_BAR_WORDS 3456
#define XB_SPIN_CAP (1u << 18)

__device__ __forceinline__ unsigned xb_ld(unsigned* p)              { return __hip_atomic_load(p, __ATOMIC_RELAXED, __HIP_MEMORY_SCOPE_AGENT); }
__device__ __forceinline__ unsigned xb_add(unsigned* p, unsigned v) { return __hip_atomic_fetch_add(p, v, __ATOMIC_RELAXED, __HIP_MEMORY_SCOPE_AGENT); }
__device__ __forceinline__ unsigned xb_xcc_id() { return (unsigned)__builtin_amdgcn_s_getreg((3 << 11) | 20) & 0xFu; }
#define XB_SPIN(cond, bar) do { unsigned _sp = 0; while (cond) { __builtin_amdgcn_s_sleep(1); \
    if ((++_sp & 255u) == 0u) { if (xb_ld(&(bar)[XB_TMO])) break; if (_sp > XB_SPIN_CAP) { atomicAdd(&(bar)[XB_TMO], 1u); break; } } } } while (0)

struct XcdBarrier {
    unsigned* bar; unsigned x;
    volatile LAS unsigned* st;
};

__device__ __forceinline__ XcdBarrier xcd_barrier_post(unsigned* bar, volatile LAS unsigned* st, bool is_t0) {
    XcdBarrier b; b.bar = bar; b.x = xb_xcc_id(); b.st = st;
    if (is_t0) (void)xb_add(&bar[XB_XCNT(b.x)], 1u);
    return b;
}
__device__ __forceinline__ void xcd_barrier_complete(unsigned* bar, unsigned x, unsigned& nloc, unsigned& nx) {
    const unsigned G = gridDim.x * gridDim.y * gridDim.z;
    unsigned sum, cnt, mine, sp = 0u;
    for (;;) {
        sum = 0u; cnt = 0u; mine = 0u;
#pragma unroll
        for (unsigned j = 0; j < 16; ++j) { const unsigned c = xb_ld(&bar[XB_XCNT(j)]); sum += c; cnt += (c > 0u) ? 1u : 0u; mine = (j == x) ? c : mine; }
        if (sum == G) break;
        __builtin_amdgcn_s_sleep(1);
        if ((++sp & 255u) == 0u) { if (xb_ld(&bar[XB_TMO])) break; if (sp > XB_SPIN_CAP) { atomicAdd(&bar[XB_TMO], 1u); break; } }
    }
    nloc = mine > 0u ? mine : 1u; nx = cnt > 0u ? cnt : 1u;
}

__device__ __forceinline__ void xcd_barrier(const XcdBarrier& b, bool is_t0) {
    asm volatile("s_waitcnt vmcnt(0)" ::: "memory");
    __syncthreads();
    if (is_t0) {
        unsigned* bar = b.bar;
        __builtin_amdgcn_s_waitcnt(0);
        unsigned nloc = b.st[0], nx = b.st[1];
        if (nloc == 0u) { xcd_barrier_complete(bar, b.x, nloc, nx); b.st[0] = nloc; b.st[1] = nx; }
        const unsigned old = xb_add(&bar[XB_XSUB(b.x)], 1u);
        const unsigned gen = old / nloc;
        if (old + 1u == (gen + 1u) * nloc) {
            __builtin_amdgcn_fence(__ATOMIC_RELEASE, "agent");
            asm volatile("s_waitcnt vmcnt(0)" ::: "memory");
            const unsigned og = xb_add(&bar[XB_TOP], 1u);
            const unsigned tg = og / nx;
            if (og + 1u == (tg + 1u) * nx) xb_add(&bar[XB_TOPGEN], 1u);
            else XB_SPIN(xb_ld(&bar[XB_TOPGEN]) == tg, bar);
            __builtin_amdgcn_fence(__ATOMIC_ACQUIRE, "agent");
            xb_add(&bar[XB_XGEN(b.x)], 1u);
            asm volatile("s_waitcnt vmcnt(0)" ::: "memory");
        } else {
            XB_SPIN(xb_ld(&bar[XB_XGEN(b.x)]) == gen, bar);
            __builtin_amdgcn_fence(__ATOMIC_ACQUIRE, "agent");
            asm volatile("s_waitcnt vmcnt(0)" ::: "memory");
        }
    }
    __syncthreads();
}
__device__ __forceinline__ void unpack8(const u32x4 w, float (&f)[8]) { f[0] = bflo(w.x); f[1] = bfhi(w.x); f[2] = bflo(w.y); f[3] = bfhi(w.y); f[4] = bflo(w.z); f[5] = bfhi(w.z); f[6] = bflo(w.w); f[7] = bfhi(w.w); }
struct Ctx { LAS unsigned char* lds; int tid, lane, wave, G, bid; };

__device__ __forceinline__ void p0_transpose_item(const float* W, int K, int N, bf16* WT, LAS float* scr, int item, int lane, bool upmap = false) {
    const int nblk = N / 32, kb = item / nblk, nb = item % nblk, k0 = 64 * kb, n0 = 32 * nb;
    const int r0 = !upmap ? n0 : (n0 < D_FF ? 256 * (n0 / 128) + (n0 % 128) : 256 * ((n0 - D_FF) / 128) + 128 + ((n0 - D_FF) % 128));
#pragma unroll 8
    for (int i = 0; i < 32; ++i) { const int kk = 2 * i + (lane >> 5); scr[kk * 33 + (lane & 31)] = __builtin_nontemporal_load(W + (size_t)(k0 + kk) * N + n0 + (lane & 31)); }
    LDS_WAIT(); asm volatile("" ::: "memory");
    const int c = lane & 7;
#pragma unroll
    for (int j = 0; j < 4; ++j) { const int n = (lane >> 3) + 8 * j; const LAS float* s = scr + (8 * c) * 33 + n;
        u32x4 o; o.x = pk2(s[0 * 33], s[1 * 33]); o.y = pk2(s[2 * 33], s[3 * 33]); o.z = pk2(s[4 * 33], s[5 * 33]); o.w = pk2(s[6 * 33], s[7 * 33]);
        *(u32x4*)(WT + (size_t)(r0 + n) * K + k0 + 8 * c) = o; }
    LDS_WAIT(); asm volatile("" ::: "memory");
}
struct P0Args { const float *x, *w_in, *w_out, *w_up, *w_down; unsigned char* ws; };
__device__ __forceinline__ void p0_prologue(const Ctx& F, const P0Args& a) {
    LAS float* scr = (LAS float*)(F.lds + F.wave * 16384);
    const int gw = F.bid * NWAVES + F.wave, NGW = F.G * NWAVES;
    constexpr int I_IN = (1024 / 64) * (IN_COLS / 32), I_OUT = (1024 / 64) * (1024 / 32), I_UP = (1024 / 64) * (UP_COLS / 32), I_DN = (D_FF / 64) * (1024 / 32);
    constexpr int PER_L = I_IN + I_OUT + I_UP + I_DN, NITEMS = DEPTH * PER_L;
    for (int it = gw; it < NITEMS; it += NGW) {
        const int l = it / PER_L; int r = it % PER_L;
        if (r < I_IN) { p0_transpose_item(a.w_in + (size_t)l * 1024 * IN_COLS, 1024, IN_COLS, (bf16*)(a.ws + WS_WIN) + (size_t)l * IN_PAD * 1024, scr, r, F.lane); continue; } r -= I_IN;
        if (r < I_OUT) { p0_transpose_item(a.w_out + (size_t)l * 1024 * 1024, 1024, 1024, (bf16*)(a.ws + WS_WOUT) + (size_t)l * 1024 * 1024, scr, r, F.lane); continue; } r -= I_OUT;
        if (r < I_UP) { p0_transpose_item(a.w_up + (size_t)l * 1024 * UP_COLS, 1024, UP_COLS, (bf16*)(a.ws + WS_WUP) + (size_t)l * UP_COLS * 1024, scr, r, F.lane, true); continue; } r -= I_UP;
        p0_transpose_item(a.w_down + (size_t)l * D_FF * 1024, D_FF, 1024, (bf16*)(a.ws + WS_WDN) + (size_t)l * 1024 * D_FF, scr, r, F.lane);
    }
    const size_t gt = (size_t)F.bid * NTHR + F.tid, NGT = (size_t)F.G * NTHR;
    for (size_t i = gt; i < (size_t)DEPTH * (IN_PAD - IN_COLS) * 1024 / 8; i += NGT) { const size_t l = i / ((IN_PAD - IN_COLS) * 128), r = i % ((IN_PAD - IN_COLS) * 128);
        *(u32x4*)((bf16*)(a.ws + WS_WIN) + (l * IN_PAD + IN_COLS) * 1024 + r * 8) = (u32x4){0u, 0u, 0u, 0u}; }
    for (size_t i = gt; i < (size_t)DEPTH * KMS_BYTES / 16; i += NGT) *(u32x4*)(a.ws + WS_KMS + i * 16) = (u32x4){0u, 0u, 0u, 0u};
    for (size_t i = gt; i < (size_t)SEQ * 32; i += NGT) { const int pos = (int)(i >> 5), k = (int)(i & 31);
        const float inv = powf(10000.0f, -(float)(2 * k) / 64.0f); const float ang = (float)pos * inv; float sn, cs; sincosf(ang, &sn, &cs);
        float* t = (float*)(a.ws + WS_ROPE) + (size_t)pos * 64; t[k] = cs; t[32 + k] = sn; }
    bf16* xb = (bf16*)(a.ws + WS_XB);
#pragma unroll 4
    for (size_t i = gt; i < (size_t)M_TOK * D_MODEL / 8; i += NGT) { const f32x4 v0 = __builtin_nontemporal_load((const f32x4*)(a.x + i * 8)), v1 = __builtin_nontemporal_load((const f32x4*)(a.x + i * 8 + 4));
        *(u32x4*)(xb + i * 8) = (u32x4){pk2(v0[0], v0[1]), pk2(v0[2], v0[3]), pk2(v1[0], v1[1]), pk2(v1[2], v1[3])}; }
}

__device__ __forceinline__ void ln_phase(const Ctx& F, const bf16* Y, const float* g, const float* bta, float* XF  , bf16* XB  , float* stats  ) {
    const int gw = F.bid * NWAVES + F.wave, NGW = F.G * NWAVES;
    float gg[2][8], bb[2][8];
#pragma unroll
    for (int j = 0; j < 2; ++j)
#pragma unroll
        for (int e = 0; e < 8; ++e) { gg[j][e] = g[512 * j + 8 * F.lane + e]; bb[j][e] = bta[512 * j + 8 * F.lane + e]; }
    for (int m0 = 4 * gw; m0 < M_TOK; m0 += 4 * NGW) {
        u32x4 raw[4][2];
#pragma unroll
        for (int rr = 0; rr < 4; ++rr)
#pragma unroll
            for (int j = 0; j < 2; ++j) raw[rr][j] = *(const u32x4*)(Y + (size_t)(m0 + rr) * D_MODEL + 512 * j + 8 * F.lane);
#pragma unroll
        for (int rr = 0; rr < 4; ++rr) {
            const int m = m0 + rr; float v[2][8]; unpack8(raw[rr][0], v[0]); unpack8(raw[rr][1], v[1]);
            float s = 0.f;
#pragma unroll
            for (int j = 0; j < 2; ++j)
#pragma unroll
                for (int e = 0; e < 8; ++e) s += v[j][e];
            const float mean = wave_sum(s) * (1.f / D_MODEL); float s2 = 0.f;
#pragma unroll
            for (int j = 0; j < 2; ++j)
#pragma unroll
                for (int e = 0; e < 8; ++e) { v[j][e] -= mean; s2 += v[j][e] * v[j][e]; }
            const float rstd = 1.0f / sqrtf(wave_sum(s2) * (1.f / D_MODEL) + LN_EPS);
            if (stats && F.lane == 0) { stats[2 * m] = mean; stats[2 * m + 1] = rstd; }
#pragma unroll
            for (int j = 0; j < 2; ++j)
#pragma unroll
                for (int e = 0; e < 8; ++e) v[j][e] = v[j][e] * rstd * gg[j][e] + bb[j][e];
            if (XF) {
#pragma unroll
                for (int j = 0; j < 2; ++j) { float* o = XF + (size_t)m * D_MODEL + 512 * j + 8 * F.lane;
                    __builtin_nontemporal_store((f32x4){v[j][0], v[j][1], v[j][2], v[j][3]}, (f32x4*)o); __builtin_nontemporal_store((f32x4){v[j][4], v[j][5], v[j][6], v[j][7]}, (f32x4*)(o + 4)); } }
            if (XB) {
#pragma unroll
                for (int j = 0; j < 2; ++j) *(u32x4*)(XB + (size_t)m * D_MODEL + 512 * j + 8 * F.lane) = (u32x4){pk2(v[j][0], v[j][1]), pk2(v[j][2], v[j][3]), pk2(v[j][4], v[j][5]), pk2(v[j][6], v[j][7])}; }
        }
    }
}

__device__ __forceinline__ void ffn_fixup_phase(const Ctx& F, bf16* G, const float* cw  , const float* last, const float* fixs, const float* fixb) {
    constexpr int NCH = D_FF / 8, NHP = M_TOK / 128;
    const size_t gt = (size_t)F.bid * NTHR + F.tid, NGT = (size_t)F.G * NTHR;
    for (size_t idx = gt; idx < (size_t)NCH * NHP; idx += NGT) {
        const int c = (int)(idx % NCH) * 8, hp = (int)(idx / NCH);
        f32x4 p2[2] = {(f32x4){0.f, 0.f, 0.f, 0.f}, (f32x4){0.f, 0.f, 0.f, 0.f}}, p1[2] = {(f32x4){0.f, 0.f, 0.f, 0.f}, (f32x4){0.f, 0.f, 0.f, 0.f}};
        if (hp % 16 != 0) {
#pragma unroll
            for (int n = 0; n < 2; ++n) { p2[n] = *(const f32x4*)(last + ((size_t)(hp - 1) * 2 + 0) * D_FF + c + 4 * n); p1[n] = *(const f32x4*)(last + ((size_t)(hp - 1) * 2 + 1) * D_FF + c + 4 * n); } }
#pragma unroll
        for (int r = 0; r < 2; ++r) { u32x4 o;
#pragma unroll
            for (int n = 0; n < 2; ++n) {
                const f32x4 w0 = *(const f32x4*)(cw + c + 4 * n), w1 = *(const f32x4*)(cw + D_FF + c + 4 * n);
                f32x4 s = *(const f32x4*)(fixs + ((size_t)hp * 2 + r) * D_FF + c + 4 * n); const f32x4 b = *(const f32x4*)(fixb + ((size_t)hp * 2 + r) * D_FF + c + 4 * n);
                if (r == 0) s += p2[n] * w0 + p1[n] * w1; else s += p1[n] * w0;
                const pg8::f32x2 g0 = pg8::gelu_pk((pg8::f32x2){s[0], s[1]}), g1 = pg8::gelu_pk((pg8::f32x2){s[2], s[3]});
                const unsigned lo = pk2(g0.x * b[0], g0.y * b[1]), hi = pk2(g1.x * b[2], g1.y * b[3]);
                if (n == 0) { o.x = lo; o.y = hi; } else { o.z = lo; o.w = hi; } }
            *(u32x4*)(G + (size_t)(128 * hp + r) * D_FF + c) = o; }
    }
}
#define NTL(p) __builtin_nontemporal_load((const u32x4*)(p))
__device__ __forceinline__ void conv_unit(const Ctx& F, const bf16* PROJ, const float* cw  , bf16* CAT, int item) {
    int tid_ = F.tid; asm volatile("" : "+v"(tid_));
    const int c = tid_ & 31, tg = tid_ >> 5, t0 = item * 256 + tg * 16;
    float w0[8], w1[8], w2[8];
#pragma unroll
    for (int e = 0; e < 8; ++e) { w0[e] = cw[c * 8 + e]; w1[e] = cw[256 + c * 8 + e]; w2[e] = cw[512 + c * 8 + e]; }
    const bf16* base = PROJ + (size_t)(c >> 3) * PG + (size_t)t0 * PR + (c & 7) * 8;
    float pm2[8], pm1[8];
    if ((t0 & (SEQ - 1)) == 0) {
#pragma unroll
        for (int e = 0; e < 8; ++e) { pm2[e] = 0.f; pm1[e] = 0.f; } }
    else { float a[8], b[8];
        unpack8(NTL(base - 2 * PR + (C_CC / 64) * PG), a); unpack8(NTL(base - 2 * PR + (C_CH / 64) * PG), b);
#pragma unroll
        for (int e = 0; e < 8; ++e) pm2[e] = a[e] * b[e];
        unpack8(NTL(base - PR + (C_CC / 64) * PG), a); unpack8(NTL(base - PR + (C_CH / 64) * PG), b);
#pragma unroll
        for (int e = 0; e < 8; ++e) pm1[e] = a[e] * b[e]; }
#pragma unroll 4
    for (int t = 0; t < 16; ++t) {
        float cb[8], cc[8], ch[8]; const bf16* row = base + (size_t)t * PR;
        unpack8(NTL(row + (C_CB / 64) * PG), cb); unpack8(NTL(row + (C_CC / 64) * PG), cc); unpack8(NTL(row + (C_CH / 64) * PG), ch);
        float o[8];
#pragma unroll
        for (int e = 0; e < 8; ++e) { const float p = cc[e] * ch[e]; o[e] = cb[e] * (w0[e] * pm2[e] + w1[e] * pm1[e] + w2[e] * p); pm2[e] = pm1[e]; pm1[e] = p; }
        *(u32x4*)(CAT + (size_t)(t0 + t) * D_MODEL + CAT_CONV + c * 8) = (u32x4){pk2(o[0], o[1]), pk2(o[2], o[3]), pk2(o[4], o[5]), pk2(o[6], o[7])};
    }
}

constexpr int MB_RING = 0, MB_SLOT = 16384, MB_KM = 65536, MB_TB = 67584, MB_UNI = 68096, MB_BL = 68160;
__device__ __forceinline__ int t5_bucket_dev(int n) {
    if (n < 16) return n;
    int bkt = 16;
    bkt += (n >= 19); bkt += (n >= 21); bkt += (n >= 24); bkt += (n >= 27); bkt += (n >= 31); bkt += (n >= 35); bkt += (n >= 40); bkt += (n >= 46);
    bkt += (n >= 52); bkt += (n >= 59); bkt += (n >= 67); bkt += (n >= 77); bkt += (n >= 87); bkt += (n >= 99); bkt += (n >= 113);
    return bkt; }
__device__ __forceinline__ void glds16(const void* g, unsigned lds_base) {
    unsigned sv; asm volatile("s_mov_b32 %0, m0\n\ts_mov_b32 m0, %2\n\ts_nop 0\n\tglobal_load_lds_dwordx4 %1, off\n\ts_mov_b32 m0, %0" : "=&s"(sv) : "v"(g), "s"(lds_base) : "memory"); }
#define MX3(a, b, c) __builtin_fmaxf(__builtin_fmaxf((a), (b)), (c))
#ifndef MB_THR
#define MB_THR 8.0f
#endif
#define MB_WAIT_BAR(N) asm volatile("s_waitcnt vmcnt(" #N ") lgkmcnt(0)\n\ts_barrier" ::: "memory")
__device__ __forceinline__ void moba_unit(const Ctx& F, const bf16* PROJ, const float* rel_bias, const float* kms  , bf16* CAT, int b, int h, int qb) {
    LAS unsigned char* lds = F.lds; const int tid = F.tid, lane = F.lane, wid = F.wave, r32 = lane & 31, hi = lane >> 5;
    LAS float* KM = (LAS float*)(lds + MB_KM); LAS float* TB = (LAS float*)(lds + MB_TB); LAS unsigned* UNI = (LAS unsigned*)(lds + MB_UNI); LAS int* BL = (LAS int*)(lds + MB_BL);
    const size_t rowb = (size_t)b * SEQ;
    const bf16* Kg = PROJ + (size_t)(C_MK / 64 + h) * PG + rowb * PR; const bf16* Vg = PROJ + (size_t)(C_MV / 64 + h) * PG + rowb * PR; const bf16* Qg = PROJ + (size_t)(C_MQ / 64 + h) * PG + rowb * PR;
    if (tid < 128) TB[tid] = rel_bias[t5_bucket_dev(tid) * 6 + h] * LOG2E;
    if (tid == 0) UNI[0] = 0u;
    if (tid < 64 * qb) KM[tid] = kms[(size_t)(b * 8 + (tid >> 6)) * 384 + h * 64 + (tid & 63)] * (1.0f / 256.0f);
    const int qrel = wid * 32 + r32;
    bf16x8 qr[4];
#pragma unroll
    for (int s = 0; s < 4; ++s) qr[s] = *(const bf16x8*)(Qg + (size_t)(256 * qb + qrel) * PR + 16 * s + 8 * hi);
    const bf16* ksrc = Kg + (size_t)(8 * wid + (lane >> 3)) * PR + (((lane & 7) ^ (lane >> 3)) * 8);
    const bf16* vsrc = Vg + (size_t)(8 * wid + (lane >> 3)) * PR + ((((lane >> 2) & 1) ^ ((lane >> 4) & 1)) * 32) + (lane & 3) * 8;
    const unsigned lds0 = (unsigned)(uintptr_t)lds;
#define MB_DMA(t) do { const int j_ = ((t) < 4) ? qb : BL[(t) >> 2]; const unsigned ro_ = (unsigned)(256 * j_ + 64 * ((t) & 3)) * PR; const unsigned sl_ = lds0 + MB_RING + ((t) & 3) * MB_SLOT + wid * 1024; \
        glds16(ksrc + ro_, (unsigned)__builtin_amdgcn_readfirstlane(sl_)); glds16(vsrc + ro_, (unsigned)__builtin_amdgcn_readfirstlane(sl_ + 8192)); } while (0)
    MB_DMA(0); MB_DMA(1);
    __syncthreads();
    unsigned sel = 0u;
    if (qb <= 3) sel = (1u << qb) - 1u;
    else {
        float v0 = -INFINITY, v1 = -INFINITY, v2 = -INFINITY; int i0 = 0, i1 = 0, i2 = 0;
#pragma unroll 1
        for (int j = 0; j < qb; ++j) { float a = 0.f;
#pragma unroll
            for (int s = 0; s < 4; ++s)
#pragma unroll
                for (int e = 0; e < 8; ++e) a += bf2f((unsigned short)qr[s][e]) * KM[j * 64 + 16 * s + 8 * hi + e];
            a += swap32_f(a);
            const bool g0 = a > v0, g1 = a > v1, g2 = a > v2;
            v2 = g1 ? v1 : (g2 ? a : v2); i2 = g1 ? i1 : (g2 ? j : i2);
            v1 = g0 ? v0 : (g1 ? a : v1); i1 = g0 ? i0 : (g1 ? j : i1);
            v0 = g0 ? a : v0; i0 = g0 ? j : i0; }
        sel = (1u << i0) | (1u << i1) | (1u << i2);
    }
    { unsigned wm = 0u;
#pragma unroll
      for (int j = 0; j < 7; ++j) if (__any((sel >> j) & 1u)) wm |= 1u << j;
      if (lane == 0 && wm) atomicOr((unsigned*)UNI, wm); }
    __syncthreads();
    if (tid == 0) { const unsigned uni = UNI[0]; int n = 0; BL[n++] = qb; for (int j = 0; j < 7; ++j) if ((uni >> j) & 1u) BL[n++] = j; BL[8] = n; }
    __syncthreads();
    const int NT = 4 * BL[8];
    float mrun = -1e30f, lrun = 0.f; f32x16 o0 = f32x16{}, o1 = f32x16{};
    const LAS char* kp0 = (const LAS char*)lds + MB_RING + r32 * 128;
    int kx[4];
#pragma unroll
    for (int s = 0; s < 4; ++s) kx[s] = (((2 * s + hi) ^ (r32 & 7)) * 16);
    const int hsw = (lane >> 3) & 1;
    const LAS char* vp0 = (const LAS char*)lds + MB_RING + 8192 + (4 * hi + ((lane & 15) >> 2)) * 128 + ((lane >> 4) & 1) * 32 + (lane & 3) * 8;
    const float tb127 = TB[127];
    for (int t = 0; t < NT; ++t) {
        const int rem = NT - 1 - t;
        if (rem >= 1) MB_WAIT_BAR(2); else MB_WAIT_BAR(0);
        if (t + 2 < NT) MB_DMA(t + 2);
        const int j = BL[t >> 2], jt = t & 3; const bool own = (t < 4);
        const bool active = own ? (64 * jt <= wid * 32 + 31) : (__any((sel >> j) & 1u) != 0);
        if (active) {
            const LAS char* kp = kp0 + (t & 3) * MB_SLOT; const LAS char* vp = vp0 + (t & 3) * MB_SLOT;
            const bool lookup = own || (j == qb - 1 && (256 + 32 * wid - 64 * jt - 63 < 128));
            const bool lanesel = own || ((sel >> j) & 1u);
            const float c0 = lookup ? 0.f : (lanesel ? tb127 - mrun : -1e30f);
            f32x16 cinit;
#pragma unroll
            for (int r = 0; r < 16; ++r) cinit[r] = c0;
            f32x16 p0 = cinit, p1 = cinit;
#pragma unroll
            for (int s = 0; s < 4; ++s) { const bf16x8 k0 = *(const LAS bf16x8*)(kp + kx[s]), k1 = *(const LAS bf16x8*)(kp + kx[s] + 4096);
                p0 = MFMA32(k0, qr[s], p0); p1 = MFMA32(k1, qr[s], p1); }
            bf16x8 vfa[4];
#pragma unroll
            for (int s = 0; s < 4; ++s) { const LAS char* va = vp + s * 2048 + hsw * 64;
                const s16x4 a0 = vtr(va), a1 = vtr(va + 1024);
                vfa[s] = (bf16x8){a0[0], a0[1], a0[2], a0[3], a1[0], a1[1], a1[2], a1[3]}; }
            int dist0 = (own ? 0 : 256 * (qb - j)) + qrel - 64 * jt - 4 * hi; asm volatile("" : "+v"(dist0));
            float mx, alpha, ps = 0.f;
            if (lookup) {
                mx = -1e30f;
#pragma unroll
                for (int r = 0; r < 16; ++r) {
                    const int d0 = dist0 - (r & 3) - 8 * (r >> 2), d1 = d0 - 32;
                    float s0 = p0[r] + TB[min(max(d0, 0), 127)], s1 = p1[r] + TB[min(max(d1, 0), 127)];
                    const bool ok0 = lanesel && (!own || d0 >= 0), ok1 = lanesel && (!own || d1 >= 0);
                    s0 = ok0 ? s0 : -1e30f; s1 = ok1 ? s1 : -1e30f;
                    p0[r] = s0; p1[r] = s1; mx = MX3(mx, s0, s1); }
                mx = fmaxf(mx, swap32_f(mx));
                const float mnew = fmaxf(mrun, mx); alpha = __builtin_amdgcn_exp2f(mrun - mnew); mrun = mnew;
#pragma unroll
                for (int r = 0; r < 16; ++r) { p0[r] = __builtin_amdgcn_exp2f(p0[r] - mnew); p1[r] = __builtin_amdgcn_exp2f(p1[r] - mnew); ps += p0[r] + p1[r]; }
            } else {
                float a = MX3(p0[0], p0[1], p1[0]), bb = MX3(p0[2], p0[3], p1[1]); a = MX3(a, p1[2], p1[3]);
#pragma unroll
                for (int r = 4; r < 16; r += 4) { a = MX3(a, p0[r], p0[r + 1]); bb = MX3(bb, p0[r + 2], p0[r + 3]); a = MX3(a, p1[r], p1[r + 1]); bb = MX3(bb, p1[r + 2], p1[r + 3]); }
                const float g = fmaxf(a, bb);
                alpha = 1.0f;
                if (__builtin_expect(__any(g > MB_THR), 0)) {
                    float dl = fmaxf(g, 0.f); dl = fmaxf(dl, swap32_f(dl));
                    mrun += dl; alpha = __builtin_amdgcn_exp2f(-dl);
#pragma unroll
                    for (int r = 0; r < 16; ++r) { p0[r] -= dl; p1[r] -= dl; } }
                float q0 = 0.f, q1 = 0.f, q2 = 0.f, q3 = 0.f;
#pragma unroll
                for (int r = 0; r < 16; r += 2) { p0[r] = __builtin_amdgcn_exp2f(p0[r]); p1[r] = __builtin_amdgcn_exp2f(p1[r]); p0[r + 1] = __builtin_amdgcn_exp2f(p0[r + 1]); p1[r + 1] = __builtin_amdgcn_exp2f(p1[r + 1]);
                    q0 += p0[r]; q1 += p1[r]; q2 += p0[r + 1]; q3 += p1[r + 1]; }
                ps = (q0 + q1) + (q2 + q3);
            }
            lrun = lrun * alpha + ps;
            if (__any(alpha != 1.0f)) {
#pragma unroll
                for (int r = 0; r < 16; ++r) { o0[r] *= alpha; o1[r] *= alpha; } }
            u32x4 pw[4];
            pw[0] = (u32x4){pk2(p0[0], p0[1]), pk2(p0[2], p0[3]), pk2(p0[4], p0[5]), pk2(p0[6], p0[7])};
            pw[1] = (u32x4){pk2(p0[8], p0[9]), pk2(p0[10], p0[11]), pk2(p0[12], p0[13]), pk2(p0[14], p0[15])};
            pw[2] = (u32x4){pk2(p1[0], p1[1]), pk2(p1[2], p1[3]), pk2(p1[4], p1[5]), pk2(p1[6], p1[7])};
            pw[3] = (u32x4){pk2(p1[8], p1[9]), pk2(p1[10], p1[11]), pk2(p1[12], p1[13]), pk2(p1[14], p1[15])};
#pragma unroll
            for (int s = 0; s < 4; ++s) { const LAS char* vb = vp + s * 2048 + (hsw ^ 1) * 64; const s16x4 c0 = vtr(vb), c1 = vtr(vb + 1024);
                const bf16x8 vfb = (bf16x8){c0[0], c0[1], c0[2], c0[3], c1[0], c1[1], c1[2], c1[3]};
                const bf16x8 pf = __builtin_bit_cast(bf16x8, pw[s]); o0 = MFMA32(vfa[s], pf, o0); o1 = MFMA32(vfb, pf, o1); }
        }
    }
#undef MB_DMA
    const float ltot = lrun + swap32_f(lrun), inv = 1.0f / ltot;
    bf16* orow = CAT + (rowb + 256 * qb + qrel) * D_MODEL + CAT_MOBA + h * 64;
#pragma unroll
    for (int g4 = 0; g4 < 4; ++g4) {
        *(u32x2*)(orow + 8 * g4 + 4 * hi) = (u32x2){pk2(o0[4 * g4] * inv, o0[4 * g4 + 1] * inv), pk2(o0[4 * g4 + 2] * inv, o0[4 * g4 + 3] * inv)};
        *(u32x2*)(orow + 32 + 8 * g4 + 4 * hi) = (u32x2){pk2(o1[4 * g4] * inv, o1[4 * g4 + 1] * inv), pk2(o1[4 * g4 + 2] * inv, o1[4 * g4 + 3] * inv)}; }
    __syncthreads();
}
constexpr int RT_Q = 0, RT_K = 16384, RT_KZ = 32768, RT_V = 49152, RT_G = 65536, RT_S = 83968, RT_ST = 93184;
struct RetRegs { u32x4 q1, q2, k1, k2, v0, v1, g0, g1; f32x4 c0, c1, s0, s1; };
__device__ __forceinline__ void ret_load(const Ctx& F, RetRegs& R, const bf16* PROJ, const float* rope, size_t tok0, int pos0, int h) {
    const int i = F.tid >> 2, p = F.tid & 3;
    const bf16* row = PROJ + (size_t)h * PG + (tok0 + i) * PR;
    R.q1 = __builtin_nontemporal_load((const u32x4*)(row + (C_RQ / 64) * PG + 8 * p)); R.q2 = __builtin_nontemporal_load((const u32x4*)(row + (C_RQ / 64) * PG + 32 + 8 * p));
    R.k1 = __builtin_nontemporal_load((const u32x4*)(row + (C_RK / 64) * PG + 8 * p)); R.k2 = __builtin_nontemporal_load((const u32x4*)(row + (C_RK / 64) * PG + 32 + 8 * p));
    R.v0 = __builtin_nontemporal_load((const u32x4*)(row + (C_RV / 64) * PG + 16 * p)); R.v1 = __builtin_nontemporal_load((const u32x4*)(row + (C_RV / 64) * PG + 16 * p + 8));
    R.g0 = __builtin_nontemporal_load((const u32x4*)(row + (C_RG / 64) * PG + 16 * p)); R.g1 = __builtin_nontemporal_load((const u32x4*)(row + (C_RG / 64) * PG + 16 * p + 8));
    const float* rt = rope + (size_t)(pos0 + i) * 64 + 8 * p;
    R.c0 = *(const f32x4*)rt; R.c1 = *(const f32x4*)(rt + 4); R.s0 = *(const f32x4*)(rt + 32); R.s1 = *(const f32x4*)(rt + 36);
}
__device__ __forceinline__ void ret_store(const Ctx& F, const RetRegs& R, float lg) {
    LAS unsigned char* lds = F.lds; const int i = F.tid >> 2, p = F.tid & 3;
    float q1[8], q2[8], k1[8], k2[8];
    unpack8(R.q1, q1); unpack8(R.q2, q2); unpack8(R.k1, k1); unpack8(R.k2, k2);
    const float zeta = __builtin_amdgcn_exp2f((float)(127 - i) * lg);
    float qa[8], qb[8], ka[8], kb[8], za[8], zb[8];
#pragma unroll
    for (int e = 0; e < 8; ++e) { const float c = e < 4 ? R.c0[e & 3] : R.c1[e & 3], s = e < 4 ? R.s0[e & 3] : R.s1[e & 3];
        qa[e] = q1[e] * c - q2[e] * s; qb[e] = q1[e] * s + q2[e] * c;
        ka[e] = (k1[e] * c - k2[e] * s) * 0.125f; kb[e] = (k1[e] * s + k2[e] * c) * 0.125f; za[e] = ka[e] * zeta; zb[e] = kb[e] * zeta; }
#define PK8(x) (u32x4){pk2(x[0], x[1]), pk2(x[2], x[3]), pk2(x[4], x[5]), pk2(x[6], x[7])}
    *(LAS u32x4*)(lds + RT_Q + p * 2048 + i * 16) = PK8(qa); *(LAS u32x4*)(lds + RT_Q + (4 + p) * 2048 + i * 16) = PK8(qb);
    *(LAS u32x4*)(lds + RT_K + p * 2048 + i * 16) = PK8(ka); *(LAS u32x4*)(lds + RT_K + (4 + p) * 2048 + i * 16) = PK8(kb);
    *(LAS u32x4*)(lds + RT_KZ + i * 64 + p * 16) = PK8(za); *(LAS u32x4*)(lds + RT_KZ + 8192 + i * 64 + p * 16) = PK8(zb);
#undef PK8
    *(LAS u32x4*)(lds + RT_V + (p >> 1) * 8192 + i * 64 + (p & 1) * 32) = R.v0; *(LAS u32x4*)(lds + RT_V + (p >> 1) * 8192 + i * 64 + (p & 1) * 32 + 16) = R.v1;
    *(LAS u32x4*)(lds + RT_G + i * 144 + p * 32) = R.g0; *(LAS u32x4*)(lds + RT_G + i * 144 + p * 32 + 16) = R.g1;
}
__device__ __forceinline__ bf16x8 tr_frag(const LAS char* p) { const s16x4 a = vtr(p), b = vtr(p + 512); return (bf16x8){a[0], a[1], a[2], a[3], b[0], b[1], b[2], b[3]}; }
__device__ __forceinline__ void ret_unit(const Ctx& F, const bf16* PROJ, const float* rope, bf16* CAT, int b, int h) {
    LAS unsigned char* lds = F.lds; const int tid = F.tid, lane = F.lane, wid = F.wave, r32 = lane & 31, hi = lane >> 5;
    const int ib = wid & 3, vh = wid >> 2, iloc = 32 * ib + r32;
    const float gam = 1.0f - __builtin_amdgcn_exp2f(-5.0f - (float)h), lg = log2f(gam), g128 = __builtin_amdgcn_exp2f(128.0f * lg);
    const float xi = __builtin_amdgcn_exp2f((float)(iloc + 1) * lg);
    const size_t rowb = (size_t)b * SEQ;
    f32x16 Sacc = f32x16{};
    for (int u = tid; u < 9216 / 4; u += NTHR) ((LAS unsigned*)(lds + RT_S))[u] = 0u;
    RetRegs RR; ret_load(F, RR, PROJ, rope, rowb, 0, h); ret_store(F, RR, lg);
    __syncthreads();
    const LAS char* trb = (const LAS char*)lds + (4 * hi + ((lane & 15) >> 2)) * 64 + ((lane >> 4) & 1) * 32 + (lane & 3) * 8;
    for (int c = 0; c < 16; ++c) {
        if (c < 15) ret_load(F, RR, PROJ, rope, rowb + 128 * (c + 1), 128 * (c + 1), h);
        bf16x8 qf[4];
#pragma unroll
        for (int s = 0; s < 4; ++s) qf[s] = *(const LAS bf16x8*)(lds + RT_Q + (2 * s + hi) * 2048 + iloc * 16);
        f32x16 cross = f32x16{};
#pragma unroll
        for (int s = 0; s < 4; ++s) { const bf16x8 sf = *(const LAS bf16x8*)(lds + RT_S + (32 * vh + r32) * 144 + (16 * s + 8 * hi) * 2); cross = MFMA32(sf, qf[s], cross); }
        f32x16 inner = f32x16{};
        for (int jb = 0; jb <= ib; ++jb) {
            f32x16 sc = f32x16{};
#pragma unroll
            for (int s = 0; s < 4; ++s) { const bf16x8 kf = *(const LAS bf16x8*)(lds + RT_K + (2 * s + hi) * 2048 + (32 * jb + r32) * 16); sc = MFMA32(kf, qf[s], sc); }
            const int dd0 = iloc - 32 * jb - 4 * hi;
#pragma unroll
            for (int r = 0; r < 16; ++r) { const int dd = dd0 - (r & 3) - 8 * (r >> 2); const float w = __builtin_amdgcn_exp2f((float)dd * lg); sc[r] = dd >= 0 ? sc[r] * w : 0.f; }
            const u32x4 pw0 = (u32x4){pk2(sc[0], sc[1]), pk2(sc[2], sc[3]), pk2(sc[4], sc[5]), pk2(sc[6], sc[7])};
            const u32x4 pw1 = (u32x4){pk2(sc[8], sc[9]), pk2(sc[10], sc[11]), pk2(sc[12], sc[13]), pk2(sc[14], sc[15])};
            const bf16x8 vf0 = tr_frag(trb + RT_V + vh * 8192 + (32 * jb) * 64), vf1 = tr_frag(trb + RT_V + vh * 8192 + (32 * jb + 16) * 64);
            inner = MFMA32(vf0, __builtin_bit_cast(bf16x8, pw0), inner); inner = MFMA32(vf1, __builtin_bit_cast(bf16x8, pw1), inner);
        }
        float s1 = 0.f, s2 = 0.f;
#pragma unroll
        for (int r = 0; r < 16; ++r) { inner[r] += xi * cross[r]; s1 += inner[r]; s2 += inner[r] * inner[r]; }
        s1 += swap32_f(s1); s2 += swap32_f(s2);
        if (hi == 0) { ((LAS float*)(lds + RT_ST))[(vh * 128 + iloc) * 2] = s1; ((LAS float*)(lds + RT_ST))[(vh * 128 + iloc) * 2 + 1] = s2; }
        u32x2 gv[4];
#pragma unroll
        for (int g4 = 0; g4 < 4; ++g4) gv[g4] = *(const LAS u32x2*)(lds + RT_G + iloc * 144 + (32 * vh + 8 * g4 + 4 * hi) * 2);
        if (wid < 4) { const int dh = wid & 1, vs = wid >> 1;
#pragma unroll
            for (int r = 0; r < 16; ++r) Sacc[r] *= g128;
#pragma unroll
            for (int s = 0; s < 8; ++s) { const bf16x8 af = tr_frag(trb + RT_KZ + dh * 8192 + (16 * s) * 64), bfr = tr_frag(trb + RT_V + vs * 8192 + (16 * s) * 64); Sacc = MFMA32(af, bfr, Sacc); } }
        __syncthreads();
        { const float o1 = ((LAS float*)(lds + RT_ST))[((vh ^ 1) * 128 + iloc) * 2], o2 = ((LAS float*)(lds + RT_ST))[((vh ^ 1) * 128 + iloc) * 2 + 1];
          const float mean = (s1 + o1) * (1.0f / 64.0f), var = (s2 + o2) * (1.0f / 64.0f) - mean * mean, rstd = 1.0f / sqrtf(fmaxf(var, 0.f) + LN_EPS);
          bf16* orow = CAT + (rowb + 128 * c + iloc) * D_MODEL + CAT_RET + h * 64 + 32 * vh;
#pragma unroll
          for (int g4 = 0; g4 < 4; ++g4) { float y[4]; const float gg[4] = {bflo(gv[g4].x), bfhi(gv[g4].x), bflo(gv[g4].y), bfhi(gv[g4].y)};
#pragma unroll
              for (int e = 0; e < 4; ++e) { const float sl = gg[e] / (1.0f + __builtin_amdgcn_exp2f(-gg[e] * LOG2E)); y[e] = (inner[4 * g4 + e] - mean) * rstd * sl; }
              *(u32x2*)(orow + 8 * g4 + 4 * hi) = (u32x2){pk2(y[0], y[1]), pk2(y[2], y[3])}; } }
        if (wid < 4) { const int dh = wid & 1, vs = wid >> 1;
#pragma unroll
            for (int g4 = 0; g4 < 4; ++g4) *(LAS u32x2*)(lds + RT_S + (32 * vs + r32) * 144 + (32 * dh + 8 * g4 + 4 * hi) * 2) = (u32x2){pk2(Sacc[4 * g4], Sacc[4 * g4 + 1]), pk2(Sacc[4 * g4 + 2], Sacc[4 * g4 + 3])}; }
        if (c < 15) ret_store(F, RR, lg);
        __syncthreads();
    }
}
struct Args {
    const float *x, *w_in, *conv_w, *w_out, *ln1_g, *ln1_b, *w_up, *ffn_conv_w, *w_down, *ln2_g, *ln2_b, *rel_bias;
    float* out; unsigned char* ws; int ph_lo, ph_hi;
};
typedef const __attribute__((address_space(4))) Args* ArgsP;
namespace pg8 {
struct EpiResid {
    static constexpr bool PERM = true, AFTER_DRAIN = false, ROWPERM = false;
    int ln, dn, li;
    __device__ __forceinline__ void init(f32x4 (&acc)[2][2][4][2], const Unit& u, int wr, int wc, int fr, int fq) const {
        const int row0 = u.pm * BM + wr * 64 + fr, col0 = u.pn * BM + wc * 32 + 8 * fq;
        ArgsP ap = (ArgsP)__builtin_amdgcn_kernarg_segment_ptr(); asm volatile("" : "+s"(ap));
        const bf16_t* yb = (const bf16_t*)(ap->ws + (ln ? WS_YB : WS_XB)); const float* stats = (const float*)(ap->ws + WS_STATS);
        const float* lg = (dn ? ap->ln1_g : ap->ln2_g) + li * 1024; const float* lb = (dn ? ap->ln1_b : ap->ln2_b) + li * 1024;
        constexpr int ldc = 1024; constexpr float alpha = DN_ALPHA;
#pragma unroll
        for (int ai = 0; ai < 2; ++ai) {
            float mean[4], rstd[4];
#pragma unroll
            for (int m = 0; m < 4; ++m) { const int row = row0 + ai * HALF + m * 16; const size_t off = (size_t)row * ldc + col0;
#pragma unroll
                for (int bj = 0; bj < 2; ++bj) { const u32x4 w = *(const u32x4*)(yb + off + bj * HALF);
                    acc[ai][bj][m][0] = (f32x4){__uint_as_float(w.x << 16), __uint_as_float(w.x & 0xffff0000u), __uint_as_float(w.y << 16), __uint_as_float(w.y & 0xffff0000u)};
                    acc[ai][bj][m][1] = (f32x4){__uint_as_float(w.z << 16), __uint_as_float(w.z & 0xffff0000u), __uint_as_float(w.w << 16), __uint_as_float(w.w & 0xffff0000u)}; }
                mean[m] = 0.f; rstd[m] = 1.f;
                if (ln) { const f32x2 st2 = *(const f32x2*)(stats + 2 * row); mean[m] = st2.x; rstd[m] = st2.y; } }
#pragma unroll
            for (int bj = 0; bj < 2; ++bj)
#pragma unroll
                for (int n = 0; n < 2; ++n) { f32x4 gv = (f32x4){alpha, alpha, alpha, alpha}, bv = (f32x4){0.f, 0.f, 0.f, 0.f};
                    if (ln) { gv = *(const f32x4*)(lg + col0 + bj * HALF + n * 4) * alpha; bv = *(const f32x4*)(lb + col0 + bj * HALF + n * 4) * alpha; }
#pragma unroll
                    for (int m = 0; m < 4; ++m) acc[ai][bj][m][n] = (acc[ai][bj][m][n] - mean[m]) * rstd[m] * gv + bv; }
            asm volatile("" ::: "memory"); __builtin_amdgcn_sched_barrier(0); }
    }
    __device__ __forceinline__ void operator()(const f32x4 (&acc)[2][2][4][2], const Unit& u, int wr, int wc, int fr, int fq) const {
        const int row0 = u.pm * BM + wr * 64 + fr, col0 = u.pn * BM + wc * 32 + 8 * fq;
        ArgsP ap = (ArgsP)__builtin_amdgcn_kernarg_segment_ptr(); asm volatile("" : "+s"(ap));
        bf16_t* yb = (bf16_t*)(ap->ws + WS_YB); constexpr int ldc = 1024;
#pragma unroll
        for (int ai = 0; ai < 2; ++ai)
#pragma unroll
            for (int m = 0; m < 4; ++m) { bf16_t* rowp = yb + (size_t)(row0 + ai * HALF + m * 16) * ldc + col0;
#pragma unroll
                for (int bj = 0; bj < 2; ++bj) { const f32x4 v0 = acc[ai][bj][m][0], v1 = acc[ai][bj][m][1];
                    u32x4 w; w.x = cvt_pk_bf16(v0[0], v0[1]); w.y = cvt_pk_bf16(v0[2], v0[3]); w.z = cvt_pk_bf16(v1[0], v1[1]); w.w = cvt_pk_bf16(v1[2], v1[3]);
                    *(u32x4*)(rowp + bj * HALF) = w; } }
    }
};
}
constexpr int N_RET = BATCH * 6, N_MOBA = BATCH * 6 * 8, N_CONV = M_TOK / 256, N_MIX = N_RET + N_MOBA + N_CONV;
constexpr int N_PHASES = 1 + 8 * DEPTH;

__global__ void __launch_bounds__(NTHR, 2) mega_fwd(Args args) {
    extern __shared__ __attribute__((aligned(16))) unsigned char lds_raw[];
    Ctx F0; F0.lds = (LAS unsigned char*)lds_raw; F0.tid = 0; F0.lane = 0; F0.wave = __builtin_amdgcn_readfirstlane((int)threadIdx.x >> 6); F0.G = gridDim.x; F0.bid = blockIdx.x;
    const int lo = args.ph_lo, hi = args.ph_hi;
    volatile LAS unsigned* bst = (volatile LAS unsigned*)(F0.lds + LDS_MISC + 32);
    { const int t0_ = (int)threadIdx.x; if (t0_ < 2) bst[t0_] = 0u; __syncthreads(); (void)xcd_barrier_post((unsigned*)(args.ws + WS_CTL) + CW_BAR, bst, t0_ == 0); }
#ifndef EN_MASK
#define EN_MASK 0xffff
#endif
#define EN(k) ((EN_MASK >> (k)) & 1)
#pragma nounroll
    for (int ph = lo; ph < hi; ++ph) {
        const int pv = (DUP_P >= 0 && ph > DUP_P) ? ph - 1 : ph;
        const int l = (pv - 1) >> 3, k = (pv - 1) & 7;
        ArgsP ap = (ArgsP)__builtin_amdgcn_kernarg_segment_ptr(); asm volatile("" : "+s"(ap));
        unsigned char* ws = ap->ws; unsigned* ctl = (unsigned*)(ws + WS_CTL);
        bf16* XB = (bf16*)(ws + WS_XB); bf16* PROJ = (bf16*)(ws + WS_PROJ); bf16* CAT = (bf16*)(ws + WS_CAT); bf16* GB = (bf16*)(ws + WS_G); const float* rope = (const float*)(ws + WS_ROPE);
        Ctx F = F0; { int t_ = F0.wave * 64 + (int)__builtin_amdgcn_mbcnt_hi(~0u, __builtin_amdgcn_mbcnt_lo(~0u, 0u)); asm volatile("" : "+v"(t_)); F.tid = t_; F.lane = t_ & 63; F.wave = __builtin_amdgcn_readfirstlane(t_ >> 6); }
        if (STAGGER_US > 0 && pv != 0 && (k == 0 || k == 4)) {
            const int sgrp = (F0.bid >> 3) & 3; const unsigned long long t0 = __builtin_amdgcn_s_memrealtime(), dl = (unsigned long long)(sgrp * STAGGER_US * 100);
            while (__builtin_amdgcn_s_memrealtime() - t0 < dl) __builtin_amdgcn_s_sleep(32); }
        if (pv == 0) { if (EN(0)) { P0Args pa{ap->x, ap->w_in, ap->w_out, ap->w_up, ap->w_down, ws}; p0_prologue(F, pa); __syncthreads(); } }
        else if (k == 0) {
            if (EN(1)) {
            pg8::Gemm g{XB, (const bf16*)(ws + WS_WIN) + (size_t)l * IN_PAD * 1024, M_TOK, IN_PAD, 1024, 1024}; pg8::StaticOrder S; S.init(M_TOK, IN_PAD, F.G, F.bid);
            pg8::EpiProj E{(DUP_P >= 0 && ph == DUP_P + 1) ? 1 : 0, PROJ, IN_PAD, (float*)(ws + WS_KMS + (size_t)l * KMS_BYTES), C_MK, C_MQ, 0.125f * LOG2E};
            pg8::gemm_phase<pg8::EpiProj, pg8::StaticOrder, GEMM_ALIGN, GEMM_SP2>(F.lds, g, S, E, F.tid); }
        }
        else if (k == 4) {
            if (EN(5)) {
            pg8::Gemm g{XB, (const bf16*)(ws + WS_WUP) + (size_t)l * UP_COLS * 1024, M_TOK, UP_COLS, 1024, 1024}; pg8::StaticOrder S; S.init(M_TOK, UP_COLS, F.G, F.bid);
            pg8::EpiGate E{GB, D_FF, ap->ffn_conv_w + (size_t)l * 3 * D_FF, D_FF, (float*)(ws + WS_LAST), (float*)(ws + WS_FIXS), (float*)(ws + WS_FIXB)};
            pg8::gemm_phase<pg8::EpiGate, pg8::StaticOrder, GEMM_ALIGN, GEMM_SP2>(F.lds, g, S, E, F.tid); }
        }
        else if (k == 2 || k == 6) {
            if (EN(3)) {
            const bool dn = (k == 6);
            const bf16* A = dn ? GB : CAT; const int K = dn ? D_FF : 1024, lda = K;
            const bf16* Bt = dn ? (const bf16*)(ws + WS_WDN) + (size_t)l * 1024 * D_FF : (const bf16*)(ws + WS_WOUT) + (size_t)l * 1024 * 1024;
            pg8::Gemm g{A, Bt, M_TOK, 1024, K, lda}; pg8::StaticOrder S; S.init(M_TOK, 1024, F.G, F.bid);
            pg8::EpiResid E{(pv != 3) ? 1 : 0, dn ? 1 : 0, dn ? l : (l > 0 ? l - 1 : 0)};
            pg8::gemm_phase<pg8::EpiResid, pg8::StaticOrder, GEMM_ALIGN, GEMM_SP2>(F.lds, g, S, E, F.tid); }
        }
        else if (k == 1) {
            if (EN(2)) {
            LAS int* slot = (LAS int*)(F.lds + LDS_MISC);
            constexpr int QRET = 24, QMOBA = 96, QCONV = 32, QTOT = QRET + QMOBA + QCONV;
            const int myq = (int)(xb_xcc_id() & 7u);
            for (int qq = 0; qq < 8; ++qq) {
                const int q = (myq + qq) & 7;
                for (;;) {
                    __syncthreads();
                    if (F.tid == 0) slot[0] = (int)atomicAdd(ctl + 1024 + (ph * 8 + q) * 16, 1u);
                    __syncthreads();
                    const int item = slot[0];
                    if (item >= QTOT) break;
                    if (item < QRET) { if (EN(9)) { const int bh = q + 8 * item; ret_unit(F, PROJ, rope, CAT, bh / 6, bh % 6); } }
                    else if (item < QRET + QMOBA) { if (EN(10)) { const int mi = item - QRET, bh = q + 8 * (mi >> 2), p = mi & 3; const float* kms = (const float*)(ws + WS_KMS + (size_t)l * KMS_BYTES);
                        moba_unit(F, PROJ, ap->rel_bias, kms, CAT, bh / 6, bh % 6, 7 - p); moba_unit(F, PROJ, ap->rel_bias, kms, CAT, bh / 6, bh % 6, p); } }
                    else conv_unit(F, PROJ, ap->conv_w + (size_t)l * 3 * 256, CAT, q * QCONV + (item - QRET - QMOBA));
                }
            } }
        }
        else if (k == 3 || k == 7) {
            if (EN(4)) {
            const bool second = (k == 7);
            const bool last = second && (l + 1 >= DEPTH);
            ln_phase(F, (const bf16*)(ws + WS_YB), (second ? ap->ln2_g : ap->ln1_g) + l * 1024, (second ? ap->ln2_b : ap->ln1_b) + l * 1024, last ? ap->out : nullptr, last ? nullptr : XB, last ? nullptr : (float*)(ws + WS_STATS)); }
        }
        else { if (EN(6)) ffn_fixup_phase(F, GB, ap->ffn_conv_w + (size_t)l * 3 * D_FF, (const float*)(ws + WS_LAST), (const float*)(ws + WS_FIXS), (const float*)(ws + WS_FIXB)); }
        if (ph + 1 < hi) { if (lo < 0) cg::this_grid().sync();
            { XcdBarrier xb_; xb_.bar = (unsigned*)(ws + WS_CTL) + CW_BAR; xb_.x = xb_xcc_id(); xb_.st = (volatile LAS unsigned*)(F0.lds + LDS_MISC + 32); xcd_barrier(xb_, F.tid == 0); } }
    }
}

#ifndef MK_PER_PHASE
#define MK_PER_PHASE 0
#endif
extern "C" void kernel_launch(void* const* d_in, const int* in_sizes, int n_in, void* d_out, int out_size, void* d_ws, size_t ws_size, hipStream_t stream) {
    static int grid = 0;
    if (grid == 0) {
        if (n_in != 12 || in_sizes[0] != M_TOK * D_MODEL || out_size != M_TOK * D_MODEL || ws_size < WS_END) { fprintf(stderr, "kernel_launch: unexpected shapes (n_in %d, ws %zu)\n", n_in, ws_size); grid = -1; return; }
        if (hipFuncSetAttribute((const void*)mega_fwd, hipFuncAttributeMaxDynamicSharedMemorySize, LDS_BYTES) != hipSuccess) { fprintf(stderr, "kernel_launch: hipFuncSetAttribute failed\n"); grid = -1; return; }
        int dev = 0, cus = 0, per_cu = 0; hipGetDevice(&dev); hipDeviceGetAttribute(&cus, hipDeviceAttributeMultiprocessorCount, dev);
        hipOccupancyMaxActiveBlocksPerMultiprocessor(&per_cu, (const void*)mega_fwd, NTHR, LDS_BYTES);
        if (per_cu < 1) { fprintf(stderr, "kernel_launch: occupancy query says %d blocks per CU\n", per_cu); }
        (void)hipGetLastError();
        grid = cus;
        if (grid != 256) fprintf(stderr, "kernel_launch: note: %d CUs\n", grid);
    }
    if (grid < 0) return;
    hipMemsetAsync((char*)d_ws + WS_CTL, 0, CTL_BYTES, stream);
    Args a{};
    a.x = (const float*)d_in[0]; a.w_in = (const float*)d_in[1]; a.conv_w = (const float*)d_in[2]; a.w_out = (const float*)d_in[3]; a.ln1_g = (const float*)d_in[4]; a.ln1_b = (const float*)d_in[5];
    a.w_up = (const float*)d_in[6]; a.ffn_conv_w = (const float*)d_in[7]; a.w_down = (const float*)d_in[8]; a.ln2_g = (const float*)d_in[9]; a.ln2_b = (const float*)d_in[10]; a.rel_bias = (const float*)d_in[11];
    a.out = (float*)d_out; a.ws = (unsigned char*)d_ws;
#if MK_PER_PHASE
    for (int p = 0; p < N_PHASES; ++p) { a.ph_lo = p; a.ph_hi = p + 1; hipLaunchKernelGGL(mega_fwd, dim3(grid), dim3(NTHR), LDS_BYTES, stream, a); }
#else
    a.ph_lo = 0; a.ph_hi = N_PHASES + (DUP_P >= 0 ? 1 : 0);
    void* kargs[] = {&a};
    hipError_t e = hipLaunchCooperativeKernel((const void*)mega_fwd, dim3(grid), dim3(NTHR), kargs, LDS_BYTES, stream);
    if (e != hipSuccess) fprintf(stderr, "kernel_launch: cooperative launch failed: %s (grid %d)\n", hipGetErrorString(e), grid);
#endif
}
```

```cpp
#include <hip/hip_runtime.h>
#include <hip/hip_cooperative_groups.h>
#include <cstdio>
#include <cstdint>
namespace cg = cooperative_groups;
#define DUP_ONLY 3
#define DUP_P -1
#define STAGGER_US 0
#define EXTRA_SYNCS 0
#define GEMM_SP2 true
#define GEMM_ALIGN true
namespace pg8 {
#define PG8_LAS __attribute__((address_space(3)))
typedef unsigned short bf16_t;
typedef short bf16x8 __attribute__((ext_vector_type(8)));
typedef float f32x4 __attribute__((ext_vector_type(4)));
typedef unsigned u32x4 __attribute__((ext_vector_type(4)));
constexpr int BM = 256, BK = 64, HALF = 128, HTB = HALF * BK * 2  , STAGE_BYTES = 8 * HTB, NXCD = 8, WGM = 8;

__host__ __device__ __forceinline__ int lds_byte(int r, int c) { const int st = (r >> 4) * 2 + (c >> 5), rr = r & 15, cc = c & 31, ob = rr * 64 + cc * 2; return st * 1024 + (ob ^ (((ob >> 9) & 1) << 5)); }
__host__ __device__ __forceinline__ void stage_rc(int b, int& R, int& C) { const int st = b / 1024, sb = b % 1024, swz = sb ^ (((sb >> 9) & 1) << 5); R = (st >> 1) * 16 + swz / 64; C = (st & 1) * 32 + (swz % 64) / 2; }
__host__ __device__ __forceinline__ int perm32(int rho) { const int n = rho >> 4, i = rho & 15; return 8 * (i >> 2) + 4 * n + (i & 3); }

#define PG8_ZERO_ACC(acc) do { _Pragma("unroll") for (int a_ = 0; a_ < 2; ++a_) _Pragma("unroll") for (int b_ = 0; b_ < 2; ++b_) _Pragma("unroll") for (int m_ = 0; m_ < 4; ++m_) _Pragma("unroll") for (int n_ = 0; n_ < 2; ++n_) acc[a_][b_][m_][n_] = (f32x4){0.f, 0.f, 0.f, 0.f}; } while (0)
struct Unit { int pm, pn; };
struct Gemm { const bf16_t* A; const bf16_t* Bt; int M, N, K, lda; };

struct StaticOrder {
    int nM, nN, nwg, G, c;
    __host__ __device__ void init(int M, int N, int G_, int c_) { nM = M / BM; nN = N / BM; nwg = nM * nN; G = G_; c = c_; }
    __host__ __device__ bool next(int i, Unit& u) const {
        const long L = (long)i * G + c; if (L >= nwg) return false;
        int wgid = (int)L; { const int q = nwg / NXCD, r = nwg % NXCD, xcd = wgid % NXCD, off = wgid / NXCD; wgid = (xcd < r ? xcd * (q + 1) : r * (q + 1) + (xcd - r) * q) + off; }
        const int nig = WGM * nN, gid = wgid / nig, fm = gid * WGM, gsz = (nM - fm) < WGM ? (nM - fm) : WGM;
        u.pm = fm + ((wgid % nig) % gsz); u.pn = (wgid % nig) / gsz; return true;
    }
    __device__ __forceinline__ void a_ready(const Unit&) const {}
    __device__ __forceinline__ void done(const Unit&) const {}
};
__device__ __forceinline__ unsigned cvt_pk_bf16(float lo, float hi) { unsigned r; asm volatile("v_cvt_pk_bf16_f32 %0, %1, %2" : "=v"(r) : "v"(lo), "v"(hi)); return r; }
typedef float f32x2 __attribute__((ext_vector_type(2)));
__device__ __forceinline__ f32x2 gelu_pk(f32x2 v) {
    const f32x2 av = __builtin_elementwise_abs(v), d = av * 0.2316418882f + 1.0f;
    f32x2 t; t.x = __builtin_amdgcn_rcpf(d.x); t.y = __builtin_amdgcn_rcpf(d.y);
    f32x2 q = t * 0.5307027145f + (-0.7265760135f); q = q * t + 0.7107068705f; q = q * t + (-0.142248368f); q = q * t + 0.127414796f; q = q * t;
    const f32x2 s = (v * v) * (-0.72134752044f);
    f32x2 e; e.x = __builtin_amdgcn_exp2f(s.x); e.y = __builtin_amdgcn_exp2f(s.y);
    const f32x2 m = v * (q * e), r = v - m;
    f32x2 o; o.x = v.x < 0.f ? m.x : r.x; o.y = v.y < 0.f ? m.y : r.y; return o;
}
__device__ __forceinline__ f32x2 gelu_mul_pk(f32x2 v, f32x2 b) {
    const f32x2 av = __builtin_elementwise_abs(v), d = av * 0.2316418882f + 1.0f;
    f32x2 t; t.x = __builtin_amdgcn_rcpf(d.x); t.y = __builtin_amdgcn_rcpf(d.y);
    f32x2 q = t * 0.5307027145f + (-0.7265760135f); q = q * t + 0.7107068705f; q = q * t + (-0.142248368f); q = q * t + 0.127414796f; q = q * t;
    const f32x2 s = (v * v) * (-0.72134752044f);
    f32x2 e; e.x = __builtin_amdgcn_exp2f(s.x); e.y = __builtin_amdgcn_exp2f(s.y);
    const f32x2 h = 0.5f - q * e;
    return (av * h + v * 0.5f) * b;
}
template <int ACT  > struct EpiBf16 {
    static constexpr bool PERM = true, AFTER_DRAIN = false, ROWPERM = false;
    __device__ __forceinline__ void init(f32x4 (&acc)[2][2][4][2], const Unit&, int, int, int, int) const { PG8_ZERO_ACC(acc); }
    bf16_t* O; int ldc; const float* bias; int split_cols; size_t split_stride;
    __device__ __forceinline__ void operator()(const f32x4 (&acc)[2][2][4][2], const Unit& u, int wr, int wc, int fr, int fq) const {
        const int row0 = u.pm * BM + wr * 64 + fr; int colt = u.pn * BM; bf16_t* base = O;
        if (split_cols) { const int t = colt / split_cols; base += (size_t)t * split_stride; colt -= t * split_cols; }
        const int col0 = colt + wc * 32 + 8 * fq, bcol0 = u.pn * BM + wc * 32 + 8 * fq;
        f32x4 bv[2][2];
#pragma unroll
        for (int bj = 0; bj < 2; ++bj)
#pragma unroll
            for (int n = 0; n < 2; ++n) bv[bj][n] = bias ? *(const f32x4*)(bias + bcol0 + bj * HALF + 4 * n) : (f32x4){0.f, 0.f, 0.f, 0.f};
#pragma unroll
        for (int ai = 0; ai < 2; ++ai)
#pragma unroll
            for (int m = 0; m < 4; ++m) { bf16_t* rowp = base + (size_t)(row0 + ai * HALF + m * 16) * ldc + col0;
#pragma unroll
                for (int bj = 0; bj < 2; ++bj) { f32x4 v0 = acc[ai][bj][m][0] + bv[bj][0], v1 = acc[ai][bj][m][1] + bv[bj][1];
                    if (ACT == 1) { f32x2 a = gelu_pk((f32x2){v0[0], v0[1]}), b = gelu_pk((f32x2){v0[2], v0[3]}), c = gelu_pk((f32x2){v1[0], v1[1]}), d = gelu_pk((f32x2){v1[2], v1[3]});
                        v0 = (f32x4){a.x, a.y, b.x, b.y}; v1 = (f32x4){c.x, c.y, d.x, d.y}; }
                    if (ACT == 2) {
#pragma unroll
                        for (int j = 0; j < 4; ++j) { v0[j] = 0.5f * v0[j] * (1.0f + erff(v0[j] * 0.70710678f)); v1[j] = 0.5f * v1[j] * (1.0f + erff(v1[j] * 0.70710678f)); } }
                    u32x4 w; w.x = cvt_pk_bf16(v0[0], v0[1]); w.y = cvt_pk_bf16(v0[2], v0[3]); w.z = cvt_pk_bf16(v1[0], v1[1]); w.w = cvt_pk_bf16(v1[2], v1[3]);
                    *(u32x4*)(rowp + bj * HALF) = w; } }
    }
};

template <class Epi, class Sched, bool ALIGN_EPI = false, bool SP2 = false>
__device__ __forceinline__ void gemm_phase(PG8_LAS unsigned char* lds, const Gemm g, const Sched& S, const Epi& E, const int tid) {
    const int wid = __builtin_amdgcn_readfirstlane(tid >> 6), lane = tid & 63, wr = wid >> 2, wc = wid & 3, fr = lane & 15, fq = lane >> 4;
    const int K = g.K, nt = K / BK;
    unsigned voffA[2], voffB[2];
#pragma unroll
    for (int i = 0; i < 2; ++i) { int R, C; stage_rc(tid * 16 + i * 8192, R, C); const int Rb = Epi::PERM ? ((R & ~31) + perm32(R & 31)) : R;
        const int Ra = Epi::ROWPERM ? (128 * (R >> 6) + 8 * (R & 15) + ((R >> 4) & 3)) : R; voffA[i] = (unsigned)(Ra * g.lda + C) * 2u; voffB[i] = (unsigned)(Rb * K + C) * 2u; }
    const size_t kstep = (size_t)(BK * 2);
    const size_t hstep = (size_t)HALF * K * 2; const size_t hstepA = (size_t)(Epi::ROWPERM ? 4 : HALF) * g.lda * 2; const size_t tstepA = (size_t)BM * g.lda * 2;
    const size_t tstep = 2 * hstep;
    const unsigned ldsw = (unsigned)wid * 1024u;
    const int aoff = lds_byte(wr * 64 + fr, fq * 8), boff = lds_byte(wc * 32 + fr, fq * 8);
#define PG8_SA(b, h) (((b) * 2 + (h)) * HTB)
#define PG8_SB(b, h) ((4 + (b) * 2 + (h)) * HTB)
#define PG8_STAGE(bufoff, gbase, voff) do { _Pragma("unroll") for (int _i = 0; _i < 2; ++_i) \
        __builtin_amdgcn_global_load_lds((const unsigned*)((const char*)(gbase) + (voff)[_i]), (PG8_LAS unsigned*)(lds + (bufoff) + ldsw + _i * 8192), 16, 0, 0); } while (0)
#define PG8_LDA(dst, b, h) do { _Pragma("unroll") for (int m = 0; m < 4; ++m) _Pragma("unroll") for (int k = 0; k < 2; ++k) dst[m][k] = *(const PG8_LAS bf16x8*)(lds + PG8_SA(b, h) + aoff + m * 2048 + k * 1024); } while (0)
#define PG8_LDB(dst, b, h) do { _Pragma("unroll") for (int n = 0; n < 2; ++n) _Pragma("unroll") for (int k = 0; k < 2; ++k) dst[n][k] = *(const PG8_LAS bf16x8*)(lds + PG8_SB(b, h) + boff + n * 2048 + k * 1024); } while (0)
#define PG8_MMA(ai, bj, At, Bt) do { __builtin_amdgcn_s_setprio(1); _Pragma("unroll") for (int m = 0; m < 4; ++m) _Pragma("unroll") for (int n = 0; n < 2; ++n) _Pragma("unroll") for (int k = 0; k < 2; ++k) \
        acc[ai][bj][m][n] = __builtin_amdgcn_mfma_f32_16x16x32_bf16(Bt[n][k], At[m][k], acc[ai][bj][m][n], 0, 0, 0); __builtin_amdgcn_s_setprio(0); } while (0)
#define PG8_WAIT_V(n) asm volatile("s_waitcnt vmcnt(" #n ")" ::: "memory")
#define PG8_WAIT_L(n) asm volatile("s_waitcnt lgkmcnt(" #n ")" ::: "memory")
#define PG8_BAR __builtin_amdgcn_s_barrier()
#define PG8_SCHED __builtin_amdgcn_sched_barrier(0)
    Unit cur, nxt; int ui = 0;
    if (!S.next(0, cur)) return;
    f32x4 acc[2][2][4][2];
    E.init(acc, cur, wr, wc, fr, fq);

    bf16x8 At[4][2], B0[2][2], B1[2][2];
    const char* cA = (const char*)g.A + (size_t)cur.pm * tstepA; const char* cB = (const char*)g.Bt + (size_t)cur.pn * tstep;
    S.a_ready(cur);
    if constexpr (SP2) {
        PG8_STAGE(PG8_SB(0, 0), cB, voffB); PG8_STAGE(PG8_SB(0, 1), cB + hstep, voffB); PG8_STAGE(PG8_SA(0, 0), cA, voffA); PG8_STAGE(PG8_SA(0, 1), cA + hstepA, voffA);
        if (wr == 1) PG8_BAR;
        PG8_WAIT_V(2); PG8_BAR;
        PG8_STAGE(PG8_SB(1, 0), cB + kstep, voffB); PG8_STAGE(PG8_SA(1, 0), cA + kstep, voffA); PG8_STAGE(PG8_SB(1, 1), cB + hstep + kstep, voffB);
        PG8_WAIT_V(6); PG8_BAR;
    } else {
        PG8_STAGE(PG8_SB(0, 0), cB, voffB); PG8_STAGE(PG8_SA(0, 0), cA, voffA); PG8_STAGE(PG8_SB(0, 1), cB + hstep, voffB); PG8_STAGE(PG8_SA(0, 1), cA + hstepA, voffA);
        if (wr == 1) PG8_BAR;
        PG8_WAIT_V(4); PG8_BAR;
        PG8_STAGE(PG8_SB(1, 0), cB + kstep, voffB); PG8_STAGE(PG8_SA(1, 0), cA + kstep, voffA); PG8_STAGE(PG8_SB(1, 1), cB + hstep + kstep, voffB);
        PG8_WAIT_V(6); PG8_BAR;
    }
    for (;;) {
        const bool has_next = S.next(ui + 1, nxt);
        const char* nA = has_next ? (const char*)g.A + (size_t)nxt.pm * tstepA : cA; const char* nB = has_next ? (const char*)g.Bt + (size_t)nxt.pn * tstep : cB;
        for (int t = 0; t < nt; t += 2) {
            const bool last = (t == nt - 2);
            const char* a1 = cA + (size_t)(t + 1) * kstep;
            const char* a2 = last ? nA : cA + (size_t)(t + 2) * kstep; const char* b2 = last ? nB : cB + (size_t)(t + 2) * kstep;
            const char* a3 = a2 + kstep; const char* b3 = b2 + kstep;
            if (last && has_next) S.a_ready(nxt);
            if constexpr (SP2) {
            PG8_LDB(B0, 0, 0); PG8_LDB(B1, 0, 1); PG8_SCHED; PG8_LDA(At, 0, 0); PG8_STAGE(PG8_SA(1, 1), a1 + hstepA, voffA);
            PG8_WAIT_V(8); PG8_WAIT_L(0); PG8_BAR; PG8_MMA(0, 0, At, B0); PG8_MMA(0, 1, At, B1); PG8_BAR; PG8_SCHED;
            PG8_LDA(At, 0, 1); PG8_STAGE(PG8_SB(0, 0), b2, voffB); PG8_STAGE(PG8_SB(0, 1), b2 + hstep, voffB); PG8_STAGE(PG8_SA(0, 0), a2, voffA);
            PG8_WAIT_V(8); PG8_WAIT_L(0); PG8_BAR; PG8_MMA(1, 0, At, B0); PG8_MMA(1, 1, At, B1); PG8_BAR; PG8_SCHED;
            PG8_LDB(B0, 1, 0); PG8_LDB(B1, 1, 1); PG8_SCHED; PG8_LDA(At, 1, 0); PG8_STAGE(PG8_SA(0, 1), a2 + hstepA, voffA);
            PG8_WAIT_V(8); PG8_WAIT_L(0); PG8_BAR; PG8_MMA(0, 0, At, B0); PG8_MMA(0, 1, At, B1); PG8_BAR; PG8_SCHED;
            PG8_LDA(At, 1, 1); PG8_STAGE(PG8_SB(1, 0), b3, voffB); PG8_STAGE(PG8_SB(1, 1), b3 + hstep, voffB); PG8_STAGE(PG8_SA(1, 0), a3, voffA);
            PG8_WAIT_V(8); PG8_WAIT_L(0); PG8_BAR; PG8_MMA(1, 0, At, B0); PG8_MMA(1, 1, At, B1); PG8_BAR; PG8_SCHED;
            } else {
            PG8_LDB(B0, 0, 0); PG8_SCHED; PG8_LDA(At, 0, 0); PG8_STAGE(PG8_SA(1, 1), a1 + hstepA, voffA);
            PG8_WAIT_L(8); PG8_BAR; PG8_WAIT_L(0); PG8_MMA(0, 0, At, B0); PG8_BAR; PG8_SCHED;
            PG8_LDB(B1, 0, 1); PG8_STAGE(PG8_SB(0, 0), b2, voffB);
            PG8_BAR; PG8_WAIT_L(0); PG8_MMA(0, 1, At, B1); PG8_BAR;
            PG8_LDA(At, 0, 1); PG8_STAGE(PG8_SA(0, 0), a2, voffA);
            PG8_BAR; PG8_WAIT_L(0); PG8_MMA(1, 0, At, B0); PG8_BAR; PG8_SCHED;
            PG8_STAGE(PG8_SB(0, 1), b2 + hstep, voffB);
            PG8_WAIT_V(6); PG8_BAR; PG8_MMA(1, 1, At, B1); PG8_BAR;
            PG8_LDB(B0, 1, 0); PG8_SCHED; PG8_LDA(At, 1, 0); PG8_STAGE(PG8_SA(0, 1), a2 + hstepA, voffA);
            PG8_WAIT_L(8); PG8_BAR; PG8_WAIT_L(0); PG8_MMA(0, 0, At, B0); PG8_BAR; PG8_SCHED;
            PG8_LDB(B1, 1, 1); PG8_STAGE(PG8_SB(1, 0), b3, voffB);
            PG8_BAR; PG8_WAIT_L(0); PG8_MMA(0, 1, At, B1); PG8_BAR;
            PG8_LDA(At, 1, 1); PG8_STAGE(PG8_SA(1, 0), a3, voffA);
            PG8_BAR; PG8_WAIT_L(0); PG8_MMA(1, 0, At, B0); PG8_BAR; PG8_SCHED;
            PG8_STAGE(PG8_SB(1, 1), b3 + hstep, voffB);
            PG8_WAIT_V(6); PG8_BAR; PG8_MMA(1, 1, At, B1); PG8_BAR;
            }
        }
        if constexpr (ALIGN_EPI) { if (wr == 0) PG8_BAR; }
        if constexpr (!Epi::AFTER_DRAIN) { E(acc, cur, wr, wc, fr, fq); S.done(cur); }
        if (!has_next) break;
        E.init(acc, nxt, wr, wc, fr, fq);
        cur = nxt; cA = nA; cB = nB; ++ui;
        if constexpr (ALIGN_EPI) { if (wr == 1) PG8_BAR; }
    }
    PG8_WAIT_V(0);
    if constexpr (!ALIGN_EPI) { if (wr == 0) PG8_BAR; }
    PG8_BAR;
    if constexpr (Epi::AFTER_DRAIN) { E.fused(acc, cur, wr, wc, fr, fq, lds, wid, lane); S.done(cur); }
#undef PG8_SA
#undef PG8_SB
#undef PG8_STAGE
#undef PG8_LDA
#undef PG8_LDB
#undef PG8_MMA
#undef PG8_WAIT_V
#undef PG8_WAIT_L
#undef PG8_BAR
#undef PG8_SCHED
}
}
namespace pg8 {
struct EpiProj {
    static constexpr bool PERM = true, AFTER_DRAIN = false, ROWPERM = false;
    __device__ __forceinline__ void init(f32x4 (&acc)[2][2][4][2], const Unit&, int, int, int, int) const { PG8_ZERO_ACC(acc); }
    int skip; bf16_t* O; int ldc; float* kms; int kc0, qc0; float qscale;
    __device__ __forceinline__ void operator()(const f32x4 (&acc)[2][2][4][2], const Unit& u, int wr, int wc, int fr, int fq) const {
        if (skip) { if (acc[0][0][0][0][0] == 123.456f) O[0] = 1; return; }
        const int row0 = u.pm * BM + wr * 64 + fr, col0 = u.pn * BM + wc * 32 + 8 * fq;
#pragma unroll
        for (int ai = 0; ai < 2; ++ai)
#pragma unroll
            for (int m = 0; m < 4; ++m) { bf16_t* rowp = O + (size_t)(row0 + ai * HALF + m * 16) * 64 + (size_t)(col0 >> 6) * ((size_t)65536 * 64) + (col0 & 63);
#pragma unroll
                for (int bj = 0; bj < 2; ++bj) { const int cq = col0 + bj * HALF - qc0; const float qs = (cq >= 0 && cq < 384) ? qscale : 1.0f;
                    const f32x4 v0 = acc[ai][bj][m][0] * qs, v1 = acc[ai][bj][m][1] * qs;
                    u32x4 w; w.x = cvt_pk_bf16(v0[0], v0[1]); w.y = cvt_pk_bf16(v0[2], v0[3]); w.z = cvt_pk_bf16(v1[0], v1[1]); w.w = cvt_pk_bf16(v1[2], v1[3]);
                    *(u32x4*)(rowp + (size_t)bj * 2 * ((size_t)65536 * 64)) = w; } }
#pragma unroll
        for (int bj = 0; bj < 2; ++bj) { const int c = col0 + bj * HALF - kc0;
            if (c >= 0 && c < 384) {
#pragma unroll
                for (int n = 0; n < 2; ++n) { f32x4 sv = (f32x4){0.f, 0.f, 0.f, 0.f};
#pragma unroll
                    for (int ai = 0; ai < 2; ++ai)
#pragma unroll
                        for (int m = 0; m < 4; ++m) sv += acc[ai][bj][m][n];
#pragma unroll
                    for (int e = 0; e < 4; ++e) { float t = sv[e]; t += __shfl_xor(t, 1); t += __shfl_xor(t, 2); t += __shfl_xor(t, 4); t += __shfl_xor(t, 8);
                        if (fr == 0) atomicAdd(kms + (size_t)u.pm * 384 + c + 4 * n + e, t); } } } }
    }
};
struct EpiGate {
    static constexpr bool PERM = true, AFTER_DRAIN = false, ROWPERM = true;
    __device__ __forceinline__ void init(f32x4 (&acc)[2][2][4][2], const Unit&, int, int, int, int) const { PG8_ZERO_ACC(acc); }
    bf16_t* G; int ldg; const float* cw; int ncol; float* last; float* fixs; float* fixb;
    __device__ __forceinline__ void operator()(const f32x4 (&acc)[2][2][4][2], const Unit& u, int wr, int wc, int fr, int fq) const {
        const int col = u.pn * HALF + wc * 32 + 8 * fq, hp = 2 * u.pm + wr;
        f32x4 w[3][2];
#pragma unroll
        for (int i = 0; i < 3; ++i) { w[i][0] = *(const f32x4*)(cw + i * ncol + col); w[i][1] = *(const f32x4*)(cw + i * ncol + col + 4); }
        f32x4 p6[2], p7[2];
#pragma unroll
        for (int n = 0; n < 2; ++n)
#pragma unroll
            for (int e = 0; e < 4; ++e) { p6[n][e] = __shfl_up(acc[1][0][2][n][e], 1); p7[n][e] = __shfl_up(acc[1][0][3][n][e], 1); }
        bf16_t* grow = G + (size_t)(u.pm * BM + 128 * wr + 8 * fr) * ldg + col;
#pragma unroll
        for (int j = 0; j < 8; ++j) {
            const int ai = j >> 2, m = j & 3;
            u32x4 o;
#pragma unroll
            for (int n = 0; n < 2; ++n) {
                f32x4 s = acc[ai][0][m][n] * w[2][n];
                if (j >= 1) s += acc[(j - 1) >> 2][0][(j - 1) & 3][n] * w[1][n]; else if (fr != 0) s += p7[n] * w[1][n];
                if (j >= 2) s += acc[(j - 2) >> 2][0][(j - 2) & 3][n] * w[0][n]; else if (fr != 0) s += (j == 0 ? p6[n] : p7[n]) * w[0][n];
                const f32x4 b = acc[ai][1][m][n];
                if (j < 2 && fr == 0) { *(f32x4*)(fixs + ((size_t)hp * 2 + j) * ncol + col + 4 * n) = s; *(f32x4*)(fixb + ((size_t)hp * 2 + j) * ncol + col + 4 * n) = b; }
                const f32x2 g0 = gelu_mul_pk((f32x2){s[0], s[1]}, (f32x2){b[0], b[1]}), g1 = gelu_mul_pk((f32x2){s[2], s[3]}, (f32x2){b[2], b[3]});
                const unsigned lo = cvt_pk_bf16(g0.x, g0.y), hi = cvt_pk_bf16(g1.x, g1.y);
                if (n == 0) { o.x = lo; o.y = hi; } else { o.z = lo; o.w = hi; }
                if (j >= 6 && fr == 15) *(f32x4*)(last + ((size_t)hp * 2 + (j - 6)) * ncol + col + 4 * n) = acc[ai][0][m][n];
            }
            if (!(j < 2 && fr == 0)) *(u32x4*)(grow + (size_t)j * ldg) = o;
        }
    }
};
}

#define LAS __attribute__((address_space(3)))
typedef unsigned short bf16;
typedef float f32x4 __attribute__((ext_vector_type(4)));
typedef float f32x16 __attribute__((ext_vector_type(16)));
typedef short bf16x8 __attribute__((ext_vector_type(8)));
typedef short s16x4 __attribute__((ext_vector_type(4)));
typedef unsigned u32x4 __attribute__((ext_vector_type(4)));
typedef unsigned u32x2 __attribute__((ext_vector_type(2)));
#define MFMA32(a, b, c) __builtin_amdgcn_mfma_f32_32x32x16_bf16(a, b, c, 0, 0, 0)
#define LDS_WAIT() asm volatile("s_waitcnt lgkmcnt(0)" ::: "memory")

constexpr int D_MODEL = 1024, BATCH = 32, SEQ = 2048, DEPTH = 2, M_TOK = BATCH * SEQ;
constexpr int PR = 64;
constexpr int IN_COLS = 3456, IN_PAD = 3584, D_FF = 2816, UP_COLS = 2 * D_FF;
constexpr int C_RQ = 0, C_RK = 384, C_RV = 768, C_RG = 1152, C_MQ = 1536, C_MK = 1920, C_MV = 2304, C_CB = 2688, C_CC = 2944, C_CH = 3200;
constexpr int CAT_RET = 0, CAT_MOBA = 384, CAT_CONV = 768;
constexpr float DN_ALPHA = 1.4142135623730951f, LN_EPS = 1e-5f, LOG2E = 1.4426950408889634f;
constexpr int NWAVES = 8, NTHR = 512;
constexpr size_t PG = (size_t)M_TOK * 64;
constexpr size_t MiB = 1u << 20;
constexpr size_t WS_CTL = 0, CTL_BYTES = 1 * MiB, WS_KMS = 65536, KMS_BYTES = 256 * 384 * 4;
constexpr size_t WS_ROPE = 1 * MiB; constexpr size_t WS_STATS = 1 * MiB + 512 * 1024;
constexpr size_t WS_WIN = 2 * MiB, WS_WOUT = 16 * MiB, WS_WUP = 20 * MiB, WS_WDN = 42 * MiB;
constexpr size_t WS_XB = 64 * MiB;
constexpr size_t WS_BIG = 192 * MiB, WS_PROJ = WS_BIG, WS_CAT = WS_BIG + 448 * MiB, WS_G = WS_BIG, WS_LAST = 768 * MiB, WS_FIXS = 780 * MiB, WS_FIXB = 792 * MiB, WS_YB = 804 * MiB, WS_END = 932 * MiB;
constexpr int LDS_MISC = 131072, LDS_BYTES = 147456;

__device__ __forceinline__ float bf2f(unsigned short b) { return __uint_as_float(((unsigned)b) << 16); }
__device__ __forceinline__ float bflo(unsigned w) { return __uint_as_float(w << 16); }
__device__ __forceinline__ float bfhi(unsigned w) { return __uint_as_float(w & 0xffff0000u); }
__device__ __forceinline__ unsigned pk2(float lo, float hi) { unsigned r; asm volatile("v_cvt_pk_bf16_f32 %0, %1, %2" : "=v"(r) : "v"(lo), "v"(hi)); return r; }
__device__ __forceinline__ int crow(int r, int hi) { return (r & 3) + 8 * (r >> 2) + 4 * hi; }
__device__ __forceinline__ s16x4 vtr(const LAS char* p) { typedef short v4i16_t __attribute__((ext_vector_type(4))); return __builtin_bit_cast(s16x4, __builtin_amdgcn_ds_read_tr16_b64_v4i16((LAS v4i16_t*)p)); }
__device__ __forceinline__ float swap32_f(float v) { return __shfl_xor(v, 32); }
__device__ __forceinline__ float wave_sum(float v) {
#pragma unroll
    for (int o = 1; o < 64; o <<= 1) v += __shfl_xor(v, o);
    return v; }

constexpr int CW_BAR = 4096;
#define XB_TMO      128
#define XB_XCNT(j)  (256  + 64 * (j))
#define XB_XSUB(j)  (1280 + 64 * (j))
#define XB_XGEN(j)  (2304 + 64 * (j))
#define XB_TOP      3328
#define XB_TOPGEN   3392
#define XCD_BAR_WORDS 3456
#define XB_SPIN_CAP (1u << 18)

__device__ __forceinline__ unsigned xb_ld(unsigned* p)              { return __hip_atomic_load(p, __ATOMIC_RELAXED, __HIP_MEMORY_SCOPE_AGENT); }
__device__ __forceinline__ unsigned xb_add(unsigned* p, unsigned v) { return __hip_atomic_fetch_add(p, v, __ATOMIC_RELAXED, __HIP_MEMORY_SCOPE_AGENT); }
__device__ __forceinline__ unsigned xb_xcc_id() { return (unsigned)__builtin_amdgcn_s_getreg((3 << 11) | 20) & 0xFu; }
#define XB_SPIN(cond, bar) do { unsigned _sp = 0; while (cond) { __builtin_amdgcn_s_sleep(1); \
    if ((++_sp & 255u) == 0u) { if (xb_ld(&(bar)[XB_TMO])) break; if (_sp > XB_SPIN_CAP) { atomicAdd(&(bar)[XB_TMO], 1u); break; } } } } while (0)

struct XcdBarrier {
    unsigned* bar; unsigned x;
    volatile LAS unsigned* st;
};

__device__ __forceinline__ XcdBarrier xcd_barrier_post(unsigned* bar, volatile LAS unsigned* st, bool is_t0) {
    XcdBarrier b; b.bar = bar; b.x = xb_xcc_id(); b.st = st;
    if (is_t0) (void)xb_add(&bar[XB_XCNT(b.x)], 1u);
    return b;
}
__device__ __forceinline__ void xcd_barrier_complete(unsigned* bar, unsigned x, unsigned& nloc, unsigned& nx) {
    const unsigned G = gridDim.x * gridDim.y * gridDim.z;
    unsigned sum, cnt, mine, sp = 0u;
    for (;;) {
        sum = 0u; cnt = 0u; mine = 0u;
#pragma unroll
        for (unsigned j = 0; j < 16; ++j) { const unsigned c = xb_ld(&bar[XB_XCNT(j)]); sum += c; cnt += (c > 0u) ? 1u : 0u; mine = (j == x) ? c : mine; }
        if (sum == G) break;
        __builtin_amdgcn_s_sleep(1);
        if ((++sp & 255u) == 0u) { if (xb_ld(&bar[XB_TMO])) break; if (sp > XB_SPIN_CAP) { atomicAdd(&bar[XB_TMO], 1u); break; } }
    }
    nloc = mine > 0u ? mine : 1u; nx = cnt > 0u ? cnt : 1u;
}

__device__ __forceinline__ void xcd_barrier(const XcdBarrier& b, bool is_t0) {
    asm volatile("s_waitcnt vmcnt(0)" ::: "memory");
    __syncthreads();
    if (is_t0) {
        unsigned* bar = b.bar;
        __builtin_amdgcn_s_waitcnt(0);
        unsigned nloc = b.st[0], nx = b.st[1];
        if (nloc == 0u) { xcd_barrier_complete(bar, b.x, nloc, nx); b.st[0] = nloc; b.st[1] = nx; }
        const unsigned old = xb_add(&bar[XB_XSUB(b.x)], 1u);
        const unsigned gen = old / nloc;
        if (old + 1u == (gen + 1u) * nloc) {
            __builtin_amdgcn_fence(__ATOMIC_RELEASE, "agent");
            asm volatile("s_waitcnt vmcnt(0)" ::: "memory");
            const unsigned og = xb_add(&bar[XB_TOP], 1u);
            const unsigned tg = og / nx;
            if (og + 1u == (tg + 1u) * nx) xb_add(&bar[XB_TOPGEN], 1u);
            else XB_SPIN(xb_ld(&bar[XB_TOPGEN]) == tg, bar);
            __builtin_amdgcn_fence(__ATOMIC_ACQUIRE, "agent");
            xb_add(&bar[XB_XGEN(b.x)], 1u);
            asm volatile("s_waitcnt vmcnt(0)" ::: "memory");
        } else {
            XB_SPIN(xb_ld(&bar[XB_XGEN(b.x)]) == gen, bar);
            __builtin_amdgcn_fence(__ATOMIC_ACQUIRE, "agent");
            asm volatile("s_waitcnt vmcnt(0)" ::: "memory");
        }
    }
    __syncthreads();
}
__device__ __forceinline__ void unpack8(const u32x4 w, float (&f)[8]) { f[0] = bflo(w.x); f[1] = bfhi(w.x); f[2] = bflo(w.y); f[3] = bfhi(w.y); f[4] = bflo(w.z); f[5] = bfhi(w.z); f[6] = bflo(w.w); f[7] = bfhi(w.w); }
struct Ctx { LAS unsigned char* lds; int tid, lane, wave, G, bid; };

__device__ __forceinline__ void p0_transpose_item(const float* W, int K, int N, bf16* WT, LAS float* scr, int item, int lane, bool upmap = false) {
    const int nblk = N / 32, kb = item / nblk, nb = item % nblk, k0 = 64 * kb, n0 = 32 * nb;
    const int r0 = !upmap ? n0 : (n0 < D_FF ? 256 * (n0 / 128) + (n0 % 128) : 256 * ((n0 - D_FF) / 128) + 128 + ((n0 - D_FF) % 128));
#pragma unroll 8
    for (int i = 0; i < 32; ++i) { const int kk = 2 * i + (lane >> 5); scr[kk * 33 + (lane & 31)] = __builtin_nontemporal_load(W + (size_t)(k0 + kk) * N + n0 + (lane & 31)); }
    LDS_WAIT(); asm volatile("" ::: "memory");
    const int c = lane & 7;
#pragma unroll
    for (int j = 0; j < 4; ++j) { const int n = (lane >> 3) + 8 * j; const LAS float* s = scr + (8 * c) * 33 + n;
        u32x4 o; o.x = pk2(s[0 * 33], s[1 * 33]); o.y = pk2(s[2 * 33], s[3 * 33]); o.z = pk2(s[4 * 33], s[5 * 33]); o.w = pk2(s[6 * 33], s[7 * 33]);
        *(u32x4*)(WT + (size_t)(r0 + n) * K + k0 + 8 * c) = o; }
    LDS_WAIT(); asm volatile("" ::: "memory");
}
struct P0Args { const float *x, *w_in, *w_out, *w_up, *w_down; unsigned char* ws; };
__device__ __forceinline__ void p0_prologue(const Ctx& F, const P0Args& a) {
    LAS float* scr = (LAS float*)(F.lds + F.wave * 16384);
    const int gw = F.bid * NWAVES + F.wave, NGW = F.G * NWAVES;
    constexpr int I_IN = (1024 / 64) * (IN_COLS / 32), I_OUT = (1024 / 64) * (1024 / 32), I_UP = (1024 / 64) * (UP_COLS / 32), I_DN = (D_FF / 64) * (1024 / 32);
    constexpr int PER_L = I_IN + I_OUT + I_UP + I_DN, NITEMS = DEPTH * PER_L;
    for (int it = gw; it < NITEMS; it += NGW) {
        const int l = it / PER_L; int r = it % PER_L;
        if (r < I_IN) { p0_transpose_item(a.w_in + (size_t)l * 1024 * IN_COLS, 1024, IN_COLS, (bf16*)(a.ws + WS_WIN) + (size_t)l * IN_PAD * 1024, scr, r, F.lane); continue; } r -= I_IN;
        if (r < I_OUT) { p0_transpose_item(a.w_out + (size_t)l * 1024 * 1024, 1024, 1024, (bf16*)(a.ws + WS_WOUT) + (size_t)l * 1024 * 1024, scr, r, F.lane); continue; } r -= I_OUT;
        if (r < I_UP) { p0_transpose_item(a.w_up + (size_t)l * 1024 * UP_COLS, 1024, UP_COLS, (bf16*)(a.ws + WS_WUP) + (size_t)l * UP_COLS * 1024, scr, r, F.lane, true); continue; } r -= I_UP;
        p0_transpose_item(a.w_down + (size_t)l * D_FF * 1024, D_FF, 1024, (bf16*)(a.ws + WS_WDN) + (size_t)l * 1024 * D_FF, scr, r, F.lane);
    }
    const size_t gt = (size_t)F.bid * NTHR + F.tid, NGT = (size_t)F.G * NTHR;
    for (size_t i = gt; i < (size_t)DEPTH * (IN_PAD - IN_COLS) * 1024 / 8; i += NGT) { const size_t l = i / ((IN_PAD - IN_COLS) * 128), r = i % ((IN_PAD - IN_COLS) * 128);
        *(u32x4*)((bf16*)(a.ws + WS_WIN) + (l * IN_PAD + IN_COLS) * 1024 + r * 8) = (u32x4){0u, 0u, 0u, 0u}; }
    for (size_t i = gt; i < (size_t)SEQ * 32; i += NGT) { const int pos = (int)(i >> 5), k = (int)(i & 31);
        const float inv = powf(10000.0f, -(float)(2 * k) / 64.0f); const float ang = (float)pos * inv; float sn, cs; sincosf(ang, &sn, &cs);
        float* t = (float*)(a.ws + WS_ROPE) + (size_t)pos * 64; t[k] = cs; t[32 + k] = sn; }
    bf16* xb = (bf16*)(a.ws + WS_XB);
#pragma unroll 4
    for (size_t i = gt; i < (size_t)M_TOK * D_MODEL / 8; i += NGT) { const f32x4 v0 = __builtin_nontemporal_load((const f32x4*)(a.x + i * 8)), v1 = __builtin_nontemporal_load((const f32x4*)(a.x + i * 8 + 4));
        *(u32x4*)(xb + i * 8) = (u32x4){pk2(v0[0], v0[1]), pk2(v0[2], v0[3]), pk2(v1[0], v1[1]), pk2(v1[2], v1[3])}; }
}

__device__ __forceinline__ void ln_phase(const Ctx& F, const bf16* Y, const float* g, const float* bta, float* XF  , bf16* XB  , float* stats  ) {
    const int gw = F.bid * NWAVES + F.wave, NGW = F.G * NWAVES;
    float gg[2][8], bb[2][8];
#pragma unroll
    for (int j = 0; j < 2; ++j)
#pragma unroll
        for (int e = 0; e < 8; ++e) { gg[j][e] = g[512 * j + 8 * F.lane + e]; bb[j][e] = bta[512 * j + 8 * F.lane + e]; }
    for (int m0 = 4 * gw; m0 < M_TOK; m0 += 4 * NGW) {
        u32x4 raw[4][2];
#pragma unroll
        for (int rr = 0; rr < 4; ++rr)
#pragma unroll
            for (int j = 0; j < 2; ++j) raw[rr][j] = *(const u32x4*)(Y + (size_t)(m0 + rr) * D_MODEL + 512 * j + 8 * F.lane);
#pragma unroll
        for (int rr = 0; rr < 4; ++rr) {
            const int m = m0 + rr; float v[2][8]; unpack8(raw[rr][0], v[0]); unpack8(raw[rr][1], v[1]);
            float s = 0.f;
#pragma unroll
            for (int j = 0; j < 2; ++j)
#pragma unroll
                for (int e = 0; e < 8; ++e) s += v[j][e];
            const float mean = wave_sum(s) * (1.f / D_MODEL); float s2 = 0.f;
#pragma unroll
            for (int j = 0; j < 2; ++j)
#pragma unroll
                for (int e = 0; e < 8; ++e) { v[j][e] -= mean; s2 += v[j][e] * v[j][e]; }
            const float rstd = 1.0f / sqrtf(wave_sum(s2) * (1.f / D_MODEL) + LN_EPS);
            if (stats && F.lane == 0) { stats[2 * m] = mean; stats[2 * m + 1] = rstd; }
#pragma unroll
            for (int j = 0; j < 2; ++j)
#pragma unroll
                for (int e = 0; e < 8; ++e) v[j][e] = v[j][e] * rstd * gg[j][e] + bb[j][e];
            if (XF) {
#pragma unroll
                for (int j = 0; j < 2; ++j) { float* o = XF + (size_t)m * D_MODEL + 512 * j + 8 * F.lane;
                    __builtin_nontemporal_store((f32x4){v[j][0], v[j][1], v[j][2], v[j][3]}, (f32x4*)o); __builtin_nontemporal_store((f32x4){v[j][4], v[j][5], v[j][6], v[j][7]}, (f32x4*)(o + 4)); } }
            if (XB) {
#pragma unroll
                for (int j = 0; j < 2; ++j) *(u32x4*)(XB + (size_t)m * D_MODEL + 512 * j + 8 * F.lane) = (u32x4){pk2(v[j][0], v[j][1]), pk2(v[j][2], v[j][3]), pk2(v[j][4], v[j][5]), pk2(v[j][6], v[j][7])}; }
        }
    }
}

__device__ __forceinline__ void ffn_fixup_phase(const Ctx& F, bf16* G, const float* cw  , const float* last, const float* fixs, const float* fixb) {
    constexpr int NCH = D_FF / 8, NHP = M_TOK / 128;
    const size_t gt = (size_t)F.bid * NTHR + F.tid, NGT = (size_t)F.G * NTHR;
    for (size_t idx = gt; idx < (size_t)NCH * NHP; idx += NGT) {
        const int c = (int)(idx % NCH) * 8, hp = (int)(idx / NCH);
        f32x4 p2[2] = {(f32x4){0.f, 0.f, 0.f, 0.f}, (f32x4){0.f, 0.f, 0.f, 0.f}}, p1[2] = {(f32x4){0.f, 0.f, 0.f, 0.f}, (f32x4){0.f, 0.f, 0.f, 0.f}};
        if (hp % 16 != 0) {
#pragma unroll
            for (int n = 0; n < 2; ++n) { p2[n] = *(const f32x4*)(last + ((size_t)(hp - 1) * 2 + 0) * D_FF + c + 4 * n); p1[n] = *(const f32x4*)(last + ((size_t)(hp - 1) * 2 + 1) * D_FF + c + 4 * n); } }
#pragma unroll
        for (int r = 0; r < 2; ++r) { u32x4 o;
#pragma unroll
            for (int n = 0; n < 2; ++n) {
                const f32x4 w0 = *(const f32x4*)(cw + c + 4 * n), w1 = *(const f32x4*)(cw + D_FF + c + 4 * n);
                f32x4 s = *(const f32x4*)(fixs + ((size_t)hp * 2 + r) * D_FF + c + 4 * n); const f32x4 b = *(const f32x4*)(fixb + ((size_t)hp * 2 + r) * D_FF + c + 4 * n);
                if (r == 0) s += p2[n] * w0 + p1[n] * w1; else s += p1[n] * w0;
                const pg8::f32x2 g0 = pg8::gelu_pk((pg8::f32x2){s[0], s[1]}), g1 = pg8::gelu_pk((pg8::f32x2){s[2], s[3]});
                const unsigned lo = pk2(g0.x * b[0], g0.y * b[1]), hi = pk2(g1.x * b[2], g1.y * b[3]);
                if (n == 0) { o.x = lo; o.y = hi; } else { o.z = lo; o.w = hi; } }
            *(u32x4*)(G + (size_t)(128 * hp + r) * D_FF + c) = o; }
    }
}
#define NTL(p) __builtin_nontemporal_load((const u32x4*)(p))
__device__ __forceinline__ void conv_unit(const Ctx& F, const bf16* PROJ, const float* cw  , bf16* CAT, int item) {
    int tid_ = F.tid; asm volatile("" : "+v"(tid_));
    const int c = tid_ & 31, tg = tid_ >> 5, t0 = item * 256 + tg * 16;
    float w0[8], w1[8], w2[8];
#pragma unroll
    for (int e = 0; e < 8; ++e) { w0[e] = cw[c * 8 + e]; w1[e] = cw[256 + c * 8 + e]; w2[e] = cw[512 + c * 8 + e]; }
    const bf16* base = PROJ + (size_t)(c >> 3) * PG + (size_t)t0 * PR + (c & 7) * 8;
    float pm2[8], pm1[8];
    if ((t0 & (SEQ - 1)) == 0) {
#pragma unroll
        for (int e = 0; e < 8; ++e) { pm2[e] = 0.f; pm1[e] = 0.f; } }
    else { float a[8], b[8];
        unpack8(NTL(base - 2 * PR + (C_CC / 64) * PG), a); unpack8(NTL(base - 2 * PR + (C_CH / 64) * PG), b);
#pragma unroll
        for (int e = 0; e < 8; ++e) pm2[e] = a[e] * b[e];
        unpack8(NTL(base - PR + (C_CC / 64) * PG), a); unpack8(NTL(base - PR + (C_CH / 64) * PG), b);
#pragma unroll
        for (int e = 0; e < 8; ++e) pm1[e] = a[e] * b[e]; }
#pragma unroll 4
    for (int t = 0; t < 16; ++t) {
        float cb[8], cc[8], ch[8]; const bf16* row = base + (size_t)t * PR;
        unpack8(NTL(row + (C_CB / 64) * PG), cb); unpack8(NTL(row + (C_CC / 64) * PG), cc); unpack8(NTL(row + (C_CH / 64) * PG), ch);
        float o[8];
#pragma unroll
        for (int e = 0; e < 8; ++e) { const float p = cc[e] * ch[e]; o[e] = cb[e] * (w0[e] * pm2[e] + w1[e] * pm1[e] + w2[e] * p); pm2[e] = pm1[e]; pm1[e] = p; }
        *(u32x4*)(CAT + (size_t)(t0 + t) * D_MODEL + CAT_CONV + c * 8) = (u32x4){pk2(o[0], o[1]), pk2(o[2], o[3]), pk2(o[4], o[5]), pk2(o[6], o[7])};
    }
}

constexpr int MB_RING = 0, MB_SLOT = 16384, MB_KM = 65536, MB_TB = 67584, MB_UNI = 68096, MB_BL = 68160;
__device__ __forceinline__ int t5_bucket_dev(int n) {
    if (n < 16) return n;
    int bkt = 16;
    bkt += (n >= 19); bkt += (n >= 21); bkt += (n >= 24); bkt += (n >= 27); bkt += (n >= 31); bkt += (n >= 35); bkt += (n >= 40); bkt += (n >= 46);
    bkt += (n >= 52); bkt += (n >= 59); bkt += (n >= 67); bkt += (n >= 77); bkt += (n >= 87); bkt += (n >= 99); bkt += (n >= 113);
    return bkt; }
__device__ __forceinline__ void glds16(const void* g, unsigned lds_base) {
    unsigned sv; asm volatile("s_mov_b32 %0, m0\n\ts_mov_b32 m0, %2\n\ts_nop 0\n\tglobal_load_lds_dwordx4 %1, off\n\ts_mov_b32 m0, %0" : "=&s"(sv) : "v"(g), "s"(lds_base) : "memory"); }
#define MX3(a, b, c) __builtin_fmaxf(__builtin_fmaxf((a), (b)), (c))
#ifndef MB_THR
#define MB_THR 8.0f
#endif
#define MB_WAIT_BAR(N) asm volatile("s_waitcnt vmcnt(" #N ") lgkmcnt(0)\n\ts_barrier" ::: "memory")
__device__ __forceinline__ void moba_unit(const Ctx& F, const bf16* PROJ, const float* rel_bias, const float* kms  , bf16* CAT, int b, int h, int qb) {
    LAS unsigned char* lds = F.lds; const int tid = F.tid, lane = F.lane, wid = F.wave, r32 = lane & 31, hi = lane >> 5;
    LAS float* KM = (LAS float*)(lds + MB_KM); LAS float* TB = (LAS float*)(lds + MB_TB); LAS unsigned* UNI = (LAS unsigned*)(lds + MB_UNI); LAS int* BL = (LAS int*)(lds + MB_BL);
    const size_t rowb = (size_t)b * SEQ;
    const bf16* Kg = PROJ + (size_t)(C_MK / 64 + h) * PG + rowb * PR; const bf16* Vg = PROJ + (size_t)(C_MV / 64 + h) * PG + rowb * PR; const bf16* Qg = PROJ + (size_t)(C_MQ / 64 + h) * PG + rowb * PR;
    if (tid < 128) TB[tid] = rel_bias[t5_bucket_dev(tid) * 6 + h] * LOG2E;
    if (tid == 0) UNI[0] = 0u;
    if (tid < 64 * qb) KM[tid] = kms[(size_t)(b * 8 + (tid >> 6)) * 384 + h * 64 + (tid & 63)] * (1.0f / 256.0f);
    const int qrel = wid * 32 + r32;
    bf16x8 qr[4];
#pragma unroll
    for (int s = 0; s < 4; ++s) qr[s] = *(const bf16x8*)(Qg + (size_t)(256 * qb + qrel) * PR + 16 * s + 8 * hi);
    const bf16* ksrc = Kg + (size_t)(8 * wid + (lane >> 3)) * PR + (((lane & 7) ^ (lane >> 3)) * 8);
    const bf16* vsrc = Vg + (size_t)(8 * wid + (lane >> 3)) * PR + ((((lane >> 2) & 1) ^ ((lane >> 4) & 1)) * 32) + (lane & 3) * 8;
    const unsigned lds0 = (unsigned)(uintptr_t)lds;
#define MB_DMA(t) do { const int j_ = ((t) < 4) ? qb : BL[(t) >> 2]; const unsigned ro_ = (unsigned)(256 * j_ + 64 * ((t) & 3)) * PR; const unsigned sl_ = lds0 + MB_RING + ((t) & 3) * MB_SLOT + wid * 1024; \
        glds16(ksrc + ro_, (unsigned)__builtin_amdgcn_readfirstlane(sl_)); glds16(vsrc + ro_, (unsigned)__builtin_amdgcn_readfirstlane(sl_ + 8192)); } while (0)
    MB_DMA(0); MB_DMA(1);
    __syncthreads();
    unsigned sel = 0u;
    if (qb <= 3) sel = (1u << qb) - 1u;
    else {
        float v0 = -INFINITY, v1 = -INFINITY, v2 = -INFINITY; int i0 = 0, i1 = 0, i2 = 0;
#pragma unroll 1
        for (int j = 0; j < qb; ++j) { float a = 0.f;
#pragma unroll
            for (int s = 0; s < 4; ++s)
#pragma unroll
                for (int e = 0; e < 8; ++e) a += bf2f((unsigned short)qr[s][e]) * KM[j * 64 + 16 * s + 8 * hi + e];
            a += swap32_f(a);
            const bool g0 = a > v0, g1 = a > v1, g2 = a > v2;
            v2 = g1 ? v1 : (g2 ? a : v2); i2 = g1 ? i1 : (g2 ? j : i2);
            v1 = g0 ? v0 : (g1 ? a : v1); i1 = g0 ? i0 : (g1 ? j : i1);
            v0 = g0 ? a : v0; i0 = g0 ? j : i0; }
        sel = (1u << i0) | (1u << i1) | (1u << i2);
    }
    { unsigned wm = 0u;
#pragma unroll
      for (int j = 0; j < 7; ++j) if (__any((sel >> j) & 1u)) wm |= 1u << j;
      if (lane == 0 && wm) atomicOr((unsigned*)UNI, wm); }
    __syncthreads();
    if (tid == 0) { const unsigned uni = UNI[0]; int n = 0; BL[n++] = qb; for (int j = 0; j < 7; ++j) if ((uni >> j) & 1u) BL[n++] = j; BL[8] = n; }
    __syncthreads();
    const int NT = 4 * BL[8];
    float mrun = -1e30f, lrun = 0.f; f32x16 o0 = f32x16{}, o1 = f32x16{};
    const LAS char* kp0 = (const LAS char*)lds + MB_RING + r32 * 128;
    const int kxb = (hi ^ (r32 & 7)) * 16;
    const int hsw = (lane >> 3) & 1;
    const LAS char* vp0 = (const LAS char*)lds + MB_RING + 8192 + (4 * hi + ((lane & 15) >> 2)) * 128 + ((lane >> 4) & 1) * 32 + (lane & 3) * 8;
    const float tb127 = TB[127];
    for (int t = 0; t < NT; ++t) {
        const int rem = NT - 1 - t;
        if (rem >= 1) MB_WAIT_BAR(2); else MB_WAIT_BAR(0);
        if (t + 2 < NT) MB_DMA(t + 2);
        const int j = BL[t >> 2], jt = t & 3; const bool own = (t < 4);
        const bool active = own ? (64 * jt <= wid * 32 + 31) : (__any((sel >> j) & 1u) != 0);
        if (active) {
            const LAS char* kp = kp0 + (t & 3) * MB_SLOT; const LAS char* vp = vp0 + (t & 3) * MB_SLOT;
            const bool lookup = own || (j == qb - 1 && (256 + 32 * wid - 64 * jt - 63 < 128));
            const bool lanesel = own || ((sel >> j) & 1u);
            const float c0 = lookup ? 0.f : (lanesel ? tb127 - mrun : -1e30f);
            f32x16 cinit;
#pragma unroll
            for (int r = 0; r < 16; ++r) cinit[r] = c0;
            f32x16 p0 = cinit, p1 = cinit;
#pragma unroll
            for (int s = 0; s < 4; ++s) { const bf16x8 k0 = *(const LAS bf16x8*)(kp + (kxb ^ (32 * s))), k1 = *(const LAS bf16x8*)(kp + (kxb ^ (32 * s)) + 4096);
                p0 = MFMA32(k0, qr[s], p0); p1 = MFMA32(k1, qr[s], p1); }
            bf16x8 vfa[4];
#pragma unroll
            for (int s = 0; s < 4; ++s) { const LAS char* va = vp + s * 2048 + hsw * 64;
                const s16x4 a0 = vtr(va), a1 = vtr(va + 1024);
                vfa[s] = (bf16x8){a0[0], a0[1], a0[2], a0[3], a1[0], a1[1], a1[2], a1[3]}; }
            int dist0 = (own ? 0 : 256 * (qb - j)) + qrel - 64 * jt - 4 * hi; asm volatile("" : "+v"(dist0));
            float mx, alpha, ps = 0.f;
            if (lookup) {
                mx = -1e30f;
#pragma unroll
                for (int r = 0; r < 16; ++r) {
                    const int d0 = dist0 - (r & 3) - 8 * (r >> 2), d1 = d0 - 32;
                    float s0 = p0[r] + TB[min(max(d0, 0), 127)], s1 = p1[r] + TB[min(max(d1, 0), 127)];
                    const bool ok0 = lanesel && (!own || d0 >= 0), ok1 = lanesel && (!own || d1 >= 0);
                    s0 = ok0 ? s0 : -1e30f; s1 = ok1 ? s1 : -1e30f;
                    p0[r] = s0; p1[r] = s1; mx = MX3(mx, s0, s1); }
                mx = fmaxf(mx, swap32_f(mx));
                const float mnew = fmaxf(mrun, mx); alpha = __builtin_amdgcn_exp2f(mrun - mnew); mrun = mnew;
#pragma unroll
                for (int r = 0; r < 16; ++r) { p0[r] = __builtin_amdgcn_exp2f(p0[r] - mnew); p1[r] = __builtin_amdgcn_exp2f(p1[r] - mnew); ps += p0[r] + p1[r]; }
            } else {
                float a = MX3(p0[0], p0[1], p1[0]), bb = MX3(p0[2], p0[3], p1[1]); a = MX3(a, p1[2], p1[3]);
#pragma unroll
                for (int r = 4; r < 16; r += 4) { a = MX3(a, p0[r], p0[r + 1]); bb = MX3(bb, p0[r + 2], p0[r + 3]); a = MX3(a, p1[r], p1[r + 1]); bb = MX3(bb, p1[r + 2], p1[r + 3]); }
                const float g = fmaxf(a, bb);
                alpha = 1.0f;
                if (__builtin_expect(__any(g > MB_THR), 0)) {
                    float dl = fmaxf(g, 0.f); dl = fmaxf(dl, swap32_f(dl));
                    mrun += dl; alpha = __builtin_amdgcn_exp2f(-dl);
#pragma unroll
                    for (int r = 0; r < 16; ++r) { p0[r] -= dl; p1[r] -= dl; } }
                float q0 = 0.f, q1 = 0.f, q2 = 0.f, q3 = 0.f;
#pragma unroll
                for (int r = 0; r < 16; r += 2) { p0[r] = __builtin_amdgcn_exp2f(p0[r]); p1[r] = __builtin_amdgcn_exp2f(p1[r]); p0[r + 1] = __builtin_amdgcn_exp2f(p0[r + 1]); p1[r + 1] = __builtin_amdgcn_exp2f(p1[r + 1]);
                    q0 += p0[r]; q1 += p1[r]; q2 += p0[r + 1]; q3 += p1[r + 1]; }
                ps = (q0 + q1) + (q2 + q3);
            }
            lrun = lrun * alpha + ps;
            if (__any(alpha != 1.0f)) {
#pragma unroll
                for (int r = 0; r < 16; ++r) { o0[r] *= alpha; o1[r] *= alpha; } }
            u32x4 pw[4];
            pw[0] = (u32x4){pk2(p0[0], p0[1]), pk2(p0[2], p0[3]), pk2(p0[4], p0[5]), pk2(p0[6], p0[7])};
            pw[1] = (u32x4){pk2(p0[8], p0[9]), pk2(p0[10], p0[11]), pk2(p0[12], p0[13]), pk2(p0[14], p0[15])};
            pw[2] = (u32x4){pk2(p1[0], p1[1]), pk2(p1[2], p1[3]), pk2(p1[4], p1[5]), pk2(p1[6], p1[7])};
            pw[3] = (u32x4){pk2(p1[8], p1[9]), pk2(p1[10], p1[11]), pk2(p1[12], p1[13]), pk2(p1[14], p1[15])};
#pragma unroll
            for (int s = 0; s < 4; ++s) { const LAS char* vb = vp + s * 2048 + (hsw ^ 1) * 64; const s16x4 c0 = vtr(vb), c1 = vtr(vb + 1024);
                const bf16x8 vfb = (bf16x8){c0[0], c0[1], c0[2], c0[3], c1[0], c1[1], c1[2], c1[3]};
                const bf16x8 pf = __builtin_bit_cast(bf16x8, pw[s]); o0 = MFMA32(vfa[s], pf, o0); o1 = MFMA32(vfb, pf, o1); }
        }
    }
#undef MB_DMA
    const float ltot = lrun + swap32_f(lrun), inv = 1.0f / ltot;
    bf16* orow = CAT + (rowb + 256 * qb + qrel) * D_MODEL + CAT_MOBA + h * 64;
#pragma unroll
    for (int g4 = 0; g4 < 4; ++g4) {
        *(u32x2*)(orow + 8 * g4 + 4 * hi) = (u32x2){pk2(o0[4 * g4] * inv, o0[4 * g4 + 1] * inv), pk2(o0[4 * g4 + 2] * inv, o0[4 * g4 + 3] * inv)};
        *(u32x2*)(orow + 32 + 8 * g4 + 4 * hi) = (u32x2){pk2(o1[4 * g4] * inv, o1[4 * g4 + 1] * inv), pk2(o1[4 * g4 + 2] * inv, o1[4 * g4 + 3] * inv)}; }
    __syncthreads();
}
constexpr int RT_Q = 0, RT_K = 16384, RT_KZ = 32768, RT_V = 49152, RT_G = 65536, RT_S = 83968, RT_ST = 93184;
struct RetRegs { u32x4 q1, q2, k1, k2, v0, v1, g0, g1; f32x4 c0, c1, s0, s1; };
__device__ __forceinline__ void ret_load(const Ctx& F, RetRegs& R, const bf16* PROJ, const float* rope, size_t tok0, int pos0, int h) {
    const int i = F.tid >> 2, p = F.tid & 3;
    const bf16* row = PROJ + (size_t)h * PG + (tok0 + i) * PR;
    R.q1 = __builtin_nontemporal_load((const u32x4*)(row + (C_RQ / 64) * PG + 8 * p)); R.q2 = __builtin_nontemporal_load((const u32x4*)(row + (C_RQ / 64) * PG + 32 + 8 * p));
    R.k1 = __builtin_nontemporal_load((const u32x4*)(row + (C_RK / 64) * PG + 8 * p)); R.k2 = __builtin_nontemporal_load((const u32x4*)(row + (C_RK / 64) * PG + 32 + 8 * p));
    R.v0 = __builtin_nontemporal_load((const u32x4*)(row + (C_RV / 64) * PG + 16 * p)); R.v1 = __builtin_nontemporal_load((const u32x4*)(row + (C_RV / 64) * PG + 16 * p + 8));
    R.g0 = __builtin_nontemporal_load((const u32x4*)(row + (C_RG / 64) * PG + 16 * p)); R.g1 = __builtin_nontemporal_load((const u32x4*)(row + (C_RG / 64) * PG + 16 * p + 8));
    const float* rt = rope + (size_t)(pos0 + i) * 64 + 8 * p;
    R.c0 = *(const f32x4*)rt; R.c1 = *(const f32x4*)(rt + 4); R.s0 = *(const f32x4*)(rt + 32); R.s1 = *(const f32x4*)(rt + 36);
}
__device__ __forceinline__ void ret_store(const Ctx& F, const RetRegs& R, float lg) {
    LAS unsigned char* lds = F.lds; const int i = F.tid >> 2, p = F.tid & 3;
    float q1[8], q2[8], k1[8], k2[8];
    unpack8(R.q1, q1); unpack8(R.q2, q2); unpack8(R.k1, k1); unpack8(R.k2, k2);
    const float zeta = __builtin_amdgcn_exp2f((float)(127 - i) * lg);
    float qa[8], qb[8], ka[8], kb[8], za[8], zb[8];
#pragma unroll
    for (int e = 0; e < 8; ++e) { const float c = e < 4 ? R.c0[e & 3] : R.c1[e & 3], s = e < 4 ? R.s0[e & 3] : R.s1[e & 3];
        qa[e] = q1[e] * c - q2[e] * s; qb[e] = q1[e] * s + q2[e] * c;
        ka[e] = (k1[e] * c - k2[e] * s) * 0.125f; kb[e] = (k1[e] * s + k2[e] * c) * 0.125f; za[e] = ka[e] * zeta; zb[e] = kb[e] * zeta; }
#define PK8(x) (u32x4){pk2(x[0], x[1]), pk2(x[2], x[3]), pk2(x[4], x[5]), pk2(x[6], x[7])}
    *(LAS u32x4*)(lds + RT_Q + p * 2048 + i * 16) = PK8(qa); *(LAS u32x4*)(lds + RT_Q + (4 + p) * 2048 + i * 16) = PK8(qb);
    *(LAS u32x4*)(lds + RT_K + p * 2048 + i * 16) = PK8(ka); *(LAS u32x4*)(lds + RT_K + (4 + p) * 2048 + i * 16) = PK8(kb);
    *(LAS u32x4*)(lds + RT_KZ + i * 64 + p * 16) = PK8(za); *(LAS u32x4*)(lds + RT_KZ + 8192 + i * 64 + p * 16) = PK8(zb);
#undef PK8
    *(LAS u32x4*)(lds + RT_V + (p >> 1) * 8192 + i * 64 + (p & 1) * 32) = R.v0; *(LAS u32x4*)(lds + RT_V + (p >> 1) * 8192 + i * 64 + (p & 1) * 32 + 16) = R.v1;
    *(LAS u32x4*)(lds + RT_G + i * 144 + p * 32) = R.g0; *(LAS u32x4*)(lds + RT_G + i * 144 + p * 32 + 16) = R.g1;
}
__device__ __forceinline__ bf16x8 tr_frag(const LAS char* p) { const s16x4 a = vtr(p), b = vtr(p + 512); return (bf16x8){a[0], a[1], a[2], a[3], b[0], b[1], b[2], b[3]}; }
__device__ __forceinline__ void ret_unit(const Ctx& F, const bf16* PROJ, const float* rope, bf16* CAT, int b, int h) {
    LAS unsigned char* lds = F.lds; const int tid = F.tid, lane = F.lane, wid = F.wave, r32 = lane & 31, hi = lane >> 5;
    const int ib = wid & 3, vh = wid >> 2, iloc = 32 * ib + r32;
    const float gam = 1.0f - __builtin_amdgcn_exp2f(-5.0f - (float)h), lg = log2f(gam), g128 = __builtin_amdgcn_exp2f(128.0f * lg);
    const float xi = __builtin_amdgcn_exp2f((float)(iloc + 1) * lg);
    const size_t rowb = (size_t)b * SEQ;
    f32x16 Sacc = f32x16{};
    for (int u = tid; u < 9216 / 4; u += NTHR) ((LAS unsigned*)(lds + RT_S))[u] = 0u;
    RetRegs RR; ret_load(F, RR, PROJ, rope, rowb, 0, h); ret_store(F, RR, lg);
    __syncthreads();
    const LAS char* trb = (const LAS char*)lds + (4 * hi + ((lane & 15) >> 2)) * 64 + ((lane >> 4) & 1) * 32 + (lane & 3) * 8;
    for (int c = 0; c < 16; ++c) {
        if (c < 15) ret_load(F, RR, PROJ, rope, rowb + 128 * (c + 1), 128 * (c + 1), h);
        bf16x8 qf[4];
#pragma unroll
        for (int s = 0; s < 4; ++s) qf[s] = *(const LAS bf16x8*)(lds + RT_Q + (2 * s + hi) * 2048 + iloc * 16);
        f32x16 cross = f32x16{};
#pragma unroll
        for (int s = 0; s < 4; ++s) { const bf16x8 sf = *(const LAS bf16x8*)(lds + RT_S + (32 * vh + r32) * 144 + (16 * s + 8 * hi) * 2); cross = MFMA32(sf, qf[s], cross); }
        f32x16 inner = f32x16{};
        for (int jb = 0; jb <= ib; ++jb) {
            f32x16 sc = f32x16{};
#pragma unroll
            for (int s = 0; s < 4; ++s) { const bf16x8 kf = *(const LAS bf16x8*)(lds + RT_K + (2 * s + hi) * 2048 + (32 * jb + r32) * 16); sc = MFMA32(kf, qf[s], sc); }
            const int dd0 = iloc - 32 * jb - 4 * hi;
#pragma unroll
            for (int r = 0; r < 16; ++r) { const int dd = dd0 - (r & 3) - 8 * (r >> 2); const float w = __builtin_amdgcn_exp2f((float)dd * lg); sc[r] = dd >= 0 ? sc[r] * w : 0.f; }
            const u32x4 pw0 = (u32x4){pk2(sc[0], sc[1]), pk2(sc[2], sc[3]), pk2(sc[4], sc[5]), pk2(sc[6], sc[7])};
            const u32x4 pw1 = (u32x4){pk2(sc[8], sc[9]), pk2(sc[10], sc[11]), pk2(sc[12], sc[13]), pk2(sc[14], sc[15])};
            const bf16x8 vf0 = tr_frag(trb + RT_V + vh * 8192 + (32 * jb) * 64), vf1 = tr_frag(trb + RT_V + vh * 8192 + (32 * jb + 16) * 64);
            inner = MFMA32(vf0, __builtin_bit_cast(bf16x8, pw0), inner); inner = MFMA32(vf1, __builtin_bit_cast(bf16x8, pw1), inner);
        }
        float s1 = 0.f, s2 = 0.f;
#pragma unroll
        for (int r = 0; r < 16; ++r) { inner[r] += xi * cross[r]; s1 += inner[r]; s2 += inner[r] * inner[r]; }
        s1 += swap32_f(s1); s2 += swap32_f(s2);
        if (hi == 0) { ((LAS float*)(lds + RT_ST))[(vh * 128 + iloc) * 2] = s1; ((LAS float*)(lds + RT_ST))[(vh * 128 + iloc) * 2 + 1] = s2; }
        u32x2 gv[4];
#pragma unroll
        for (int g4 = 0; g4 < 4; ++g4) gv[g4] = *(const LAS u32x2*)(lds + RT_G + iloc * 144 + (32 * vh + 8 * g4 + 4 * hi) * 2);
        if (wid < 4) { const int dh = wid & 1, vs = wid >> 1;
#pragma unroll
            for (int r = 0; r < 16; ++r) Sacc[r] *= g128;
#pragma unroll
            for (int s = 0; s < 8; ++s) { const bf16x8 af = tr_frag(trb + RT_KZ + dh * 8192 + (16 * s) * 64), bfr = tr_frag(trb + RT_V + vs * 8192 + (16 * s) * 64); Sacc = MFMA32(af, bfr, Sacc); } }
        __syncthreads();
        { const float o1 = ((LAS float*)(lds + RT_ST))[((vh ^ 1) * 128 + iloc) * 2], o2 = ((LAS float*)(lds + RT_ST))[((vh ^ 1) * 128 + iloc) * 2 + 1];
          const float mean = (s1 + o1) * (1.0f / 64.0f), var = (s2 + o2) * (1.0f / 64.0f) - mean * mean, rstd = 1.0f / sqrtf(fmaxf(var, 0.f) + LN_EPS);
          bf16* orow = CAT + (rowb + 128 * c + iloc) * D_MODEL + CAT_RET + h * 64 + 32 * vh;
#pragma unroll
          for (int g4 = 0; g4 < 4; ++g4) { float y[4]; const float gg[4] = {bflo(gv[g4].x), bfhi(gv[g4].x), bflo(gv[g4].y), bfhi(gv[g4].y)};
#pragma unroll
              for (int e = 0; e < 4; ++e) { const float sl = gg[e] / (1.0f + __builtin_amdgcn_exp2f(-gg[e] * LOG2E)); y[e] = (inner[4 * g4 + e] - mean) * rstd * sl; }
              *(u32x2*)(orow + 8 * g4 + 4 * hi) = (u32x2){pk2(y[0], y[1]), pk2(y[2], y[3])}; } }
        if (wid < 4) { const int dh = wid & 1, vs = wid >> 1;
#pragma unroll
            for (int g4 = 0; g4 < 4; ++g4) *(LAS u32x2*)(lds + RT_S + (32 * vs + r32) * 144 + (32 * dh + 8 * g4 + 4 * hi) * 2) = (u32x2){pk2(Sacc[4 * g4], Sacc[4 * g4 + 1]), pk2(Sacc[4 * g4 + 2], Sacc[4 * g4 + 3])}; }
        if (c < 15) ret_store(F, RR, lg);
        __syncthreads();
    }
}
struct Args {
    const float *x, *w_in, *conv_w, *w_out, *ln1_g, *ln1_b, *w_up, *ffn_conv_w, *w_down, *ln2_g, *ln2_b, *rel_bias;
    float* out; unsigned char* ws; int ph_lo, ph_hi;
};
typedef const __attribute__((address_space(4))) Args* ArgsP;
namespace pg8 {
struct EpiResid {
    static constexpr bool PERM = true, AFTER_DRAIN = false, ROWPERM = false;
    int ln, dn, li;
    __device__ __forceinline__ void init(f32x4 (&acc)[2][2][4][2], const Unit& u, int wr, int wc, int fr, int fq) const {
        const int row0 = u.pm * BM + wr * 64 + fr, col0 = u.pn * BM + wc * 32 + 8 * fq;
        ArgsP ap = (ArgsP)__builtin_amdgcn_kernarg_segment_ptr(); asm volatile("" : "+s"(ap));
        const bf16_t* yb = (const bf16_t*)(ap->ws + (ln ? WS_YB : WS_XB)); const float* stats = (const float*)(ap->ws + WS_STATS);
        const float* lg = (dn ? ap->ln1_g : ap->ln2_g) + li * 1024; const float* lb = (dn ? ap->ln1_b : ap->ln2_b) + li * 1024;
        constexpr int ldc = 1024; constexpr float alpha = DN_ALPHA;
#pragma unroll
        for (int ai = 0; ai < 2; ++ai) {
            float mean[4], rstd[4];
#pragma unroll
            for (int m = 0; m < 4; ++m) { const int row = row0 + ai * HALF + m * 16; const size_t off = (size_t)row * ldc + col0;
#pragma unroll
                for (int bj = 0; bj < 2; ++bj) { const u32x4 w = *(const u32x4*)(yb + off + bj * HALF);
                    acc[ai][bj][m][0] = (f32x4){__uint_as_float(w.x << 16), __uint_as_float(w.x & 0xffff0000u), __uint_as_float(w.y << 16), __uint_as_float(w.y & 0xffff0000u)};
                    acc[ai][bj][m][1] = (f32x4){__uint_as_float(w.z << 16), __uint_as_float(w.z & 0xffff0000u), __uint_as_float(w.w << 16), __uint_as_float(w.w & 0xffff0000u)}; }
                mean[m] = 0.f; rstd[m] = 1.f;
                if (ln) { const f32x2 st2 = *(const f32x2*)(stats + 2 * row); mean[m] = st2.x; rstd[m] = st2.y; } }
#pragma unroll
            for (int bj = 0; bj < 2; ++bj)
#pragma unroll
                for (int n = 0; n < 2; ++n) { f32x4 gv = (f32x4){alpha, alpha, alpha, alpha}, bv = (f32x4){0.f, 0.f, 0.f, 0.f};
                    if (ln) { gv = *(const f32x4*)(lg + col0 + bj * HALF + n * 4) * alpha; bv = *(const f32x4*)(lb + col0 + bj * HALF + n * 4) * alpha; }
#pragma unroll
                    for (int m = 0; m < 4; ++m) acc[ai][bj][m][n] = (acc[ai][bj][m][n] - mean[m]) * rstd[m] * gv + bv; }
            asm volatile("" ::: "memory"); __builtin_amdgcn_sched_barrier(0); }
    }
    __device__ __forceinline__ void operator()(const f32x4 (&acc)[2][2][4][2], const Unit& u, int wr, int wc, int fr, int fq) const {
        const int row0 = u.pm * BM + wr * 64 + fr, col0 = u.pn * BM + wc * 32 + 8 * fq;
        ArgsP ap = (ArgsP)__builtin_amdgcn_kernarg_segment_ptr(); asm volatile("" : "+s"(ap));
        bf16_t* yb = (bf16_t*)(ap->ws + WS_YB); constexpr int ldc = 1024;
#pragma unroll
        for (int ai = 0; ai < 2; ++ai)
#pragma unroll
            for (int m = 0; m < 4; ++m) { bf16_t* rowp = yb + (size_t)(row0 + ai * HALF + m * 16) * ldc + col0;
#pragma unroll
                for (int bj = 0; bj < 2; ++bj) { const f32x4 v0 = acc[ai][bj][m][0], v1 = acc[ai][bj][m][1];
                    u32x4 w; w.x = cvt_pk_bf16(v0[0], v0[1]); w.y = cvt_pk_bf16(v0[2], v0[3]); w.z = cvt_pk_bf16(v1[0], v1[1]); w.w = cvt_pk_bf16(v1[2], v1[3]);
                    *(u32x4*)(rowp + bj * HALF) = w; } }
    }
};
}
constexpr int N_RET = BATCH * 6, N_MOBA = BATCH * 6 * 8, N_CONV = M_TOK / 256, N_MIX = N_RET + N_MOBA + N_CONV;
constexpr int N_PHASES = 1 + 8 * DEPTH;

__global__ void __launch_bounds__(NTHR, 2) mega_fwd(Args args) {
    extern __shared__ __attribute__((aligned(16))) unsigned char lds_raw[];
    Ctx F0; F0.lds = (LAS unsigned char*)lds_raw; F0.tid = 0; F0.lane = 0; F0.wave = __builtin_amdgcn_readfirstlane((int)threadIdx.x >> 6); F0.G = gridDim.x; F0.bid = blockIdx.x;
    const int lo = args.ph_lo, hi = args.ph_hi;
    volatile LAS unsigned* bst = (volatile LAS unsigned*)(F0.lds + LDS_MISC + 32);
    { const int t0_ = (int)threadIdx.x; if (t0_ < 2) bst[t0_] = 0u; __syncthreads(); (void)xcd_barrier_post((unsigned*)(args.ws + WS_CTL) + CW_BAR, bst, t0_ == 0); }
#ifndef EN_MASK
#define EN_MASK 0xffff
#endif
#define EN(k) ((EN_MASK >> (k)) & 1)
#pragma nounroll
    for (int ph = lo; ph < hi; ++ph) {
        const int pv = (DUP_P >= 0 && ph > DUP_P) ? ph - 1 : ph;
        const int l = (pv - 1) >> 3, k = (pv - 1) & 7;
        ArgsP ap = (ArgsP)__builtin_amdgcn_kernarg_segment_ptr(); asm volatile("" : "+s"(ap));
        unsigned char* ws = ap->ws; unsigned* ctl = (unsigned*)(ws + WS_CTL);
        bf16* XB = (bf16*)(ws + WS_XB); bf16* PROJ = (bf16*)(ws + WS_PROJ); bf16* CAT = (bf16*)(ws + WS_CAT); bf16* GB = (bf16*)(ws + WS_G); const float* rope = (const float*)(ws + WS_ROPE);
        Ctx F = F0; { int t_ = F0.wave * 64 + (int)__builtin_amdgcn_mbcnt_hi(~0u, __builtin_amdgcn_mbcnt_lo(~0u, 0u)); asm volatile("" : "+v"(t_)); F.tid = t_; F.lane = t_ & 63; F.wave = __builtin_amdgcn_readfirstlane(t_ >> 6); }
        if (STAGGER_US > 0 && pv != 0 && (k == 0 || k == 4)) {
            const int sgrp = (F0.bid >> 3) & 3; const unsigned long long t0 = __builtin_amdgcn_s_memrealtime(), dl = (unsigned long long)(sgrp * STAGGER_US * 100);
            while (__builtin_amdgcn_s_memrealtime() - t0 < dl) __builtin_amdgcn_s_sleep(32); }
        if (pv == 0) { if (EN(0)) { P0Args pa{ap->x, ap->w_in, ap->w_out, ap->w_up, ap->w_down, ws}; p0_prologue(F, pa); __syncthreads(); } }
        else if (k == 0) {
            if (EN(1)) {
            pg8::Gemm g{XB, (const bf16*)(ws + WS_WIN) + (size_t)l * IN_PAD * 1024, M_TOK, IN_PAD, 1024, 1024}; pg8::StaticOrder S; S.init(M_TOK, IN_PAD, F.G, F.bid);
            pg8::EpiProj E{(DUP_P >= 0 && ph == DUP_P + 1) ? 1 : 0, PROJ, IN_PAD, (float*)(ws + WS_KMS + (size_t)l * KMS_BYTES), C_MK, C_MQ, 0.125f * LOG2E};
            pg8::gemm_phase<pg8::EpiProj, pg8::StaticOrder, GEMM_ALIGN, GEMM_SP2>(F.lds, g, S, E, F.tid); }
        }
        else if (k == 4) {
            if (EN(5)) {
            pg8::Gemm g{XB, (const bf16*)(ws + WS_WUP) + (size_t)l * UP_COLS * 1024, M_TOK, UP_COLS, 1024, 1024}; pg8::StaticOrder S; S.init(M_TOK, UP_COLS, F.G, F.bid);
            pg8::EpiGate E{GB, D_FF, ap->ffn_conv_w + (size_t)l * 3 * D_FF, D_FF, (float*)(ws + WS_LAST), (float*)(ws + WS_FIXS), (float*)(ws + WS_FIXB)};
            pg8::gemm_phase<pg8::EpiGate, pg8::StaticOrder, GEMM_ALIGN, GEMM_SP2>(F.lds, g, S, E, F.tid); }
        }
        else if (k == 2 || k == 6) {
            if (EN(3)) {
            const bool dn = (k == 6);
            const bf16* A = dn ? GB : CAT; const int K = dn ? D_FF : 1024, lda = K;
            const bf16* Bt = dn ? (const bf16*)(ws + WS_WDN) + (size_t)l * 1024 * D_FF : (const bf16*)(ws + WS_WOUT) + (size_t)l * 1024 * 1024;
            pg8::Gemm g{A, Bt, M_TOK, 1024, K, lda}; pg8::StaticOrder S; S.init(M_TOK, 1024, F.G, F.bid);
            pg8::EpiResid E{(pv != 3) ? 1 : 0, dn ? 1 : 0, dn ? l : (l > 0 ? l - 1 : 0)};
            pg8::gemm_phase<pg8::EpiResid, pg8::StaticOrder, GEMM_ALIGN, GEMM_SP2>(F.lds, g, S, E, F.tid); }
        }
        else if (k == 1) {
            if (EN(2)) {
            LAS int* slot = (LAS int*)(F.lds + LDS_MISC);
            constexpr int QRET = 24, QMOBA = 96, QCONV = 32, QTOT = QRET + QMOBA + QCONV;
            const int myq = (int)(xb_xcc_id() & 7u);
            for (int qq = 0; qq < 8; ++qq) {
                const int q = (myq + qq) & 7;
                for (;;) {
                    __syncthreads();
                    if (F.tid == 0) slot[0] = (int)atomicAdd(ctl + 1024 + (ph * 8 + q) * 16, 1u);
                    __syncthreads();
                    const int item = slot[0];
                    if (item >= QTOT) break;
                    if (item < QRET) { if (EN(9)) { const int bh = q + 8 * item; ret_unit(F, PROJ, rope, CAT, bh / 6, bh % 6); } }
                    else if (item < QRET + QMOBA) { if (EN(10)) { const int mi = item - QRET, bh = q + 8 * (mi >> 2), p = mi & 3; const float* kms = (const float*)(ws + WS_KMS + (size_t)l * KMS_BYTES);
                        moba_unit(F, PROJ, ap->rel_bias, kms, CAT, bh / 6, bh % 6, 7 - p); moba_unit(F, PROJ, ap->rel_bias, kms, CAT, bh / 6, bh % 6, p); } }
                    else conv_unit(F, PROJ, ap->conv_w + (size_t)l * 3 * 256, CAT, q * QCONV + (item - QRET - QMOBA));
                }
            } }
        }
        else if (k == 3 || k == 7) {
            if (EN(4)) {
            const bool second = (k == 7);
            const bool last = second && (l + 1 >= DEPTH);
            ln_phase(F, (const bf16*)(ws + WS_YB), (second ? ap->ln2_g : ap->ln1_g) + l * 1024, (second ? ap->ln2_b : ap->ln1_b) + l * 1024, last ? ap->out : nullptr, last ? nullptr : XB, last ? nullptr : (float*)(ws + WS_STATS)); }
        }
        else { if (EN(6)) ffn_fixup_phase(F, GB, ap->ffn_conv_w + (size_t)l * 3 * D_FF, (const float*)(ws + WS_LAST), (const float*)(ws + WS_FIXS), (const float*)(ws + WS_FIXB)); }
        if (ph + 1 < hi) { if (lo < 0) cg::this_grid().sync();
            { XcdBarrier xb_; xb_.bar = (unsigned*)(ws + WS_CTL) + CW_BAR; xb_.x = xb_xcc_id(); xb_.st = (volatile LAS unsigned*)(F0.lds + LDS_MISC + 32); xcd_barrier(xb_, F.tid == 0); } }
    }
}

#ifndef MK_PER_PHASE
#define MK_PER_PHASE 0
#endif
extern "C" void kernel_launch(void* const* d_in, const int* in_sizes, int n_in, void* d_out, int out_size, void* d_ws, size_t ws_size, hipStream_t stream) {
    static int grid = 0;
    if (grid == 0) {
        if (n_in != 12 || in_sizes[0] != M_TOK * D_MODEL || out_size != M_TOK * D_MODEL || ws_size < WS_END) { fprintf(stderr, "kernel_launch: unexpected shapes (n_in %d, ws %zu)\n", n_in, ws_size); grid = -1; return; }
        if (hipFuncSetAttribute((const void*)mega_fwd, hipFuncAttributeMaxDynamicSharedMemorySize, LDS_BYTES) != hipSuccess) { fprintf(stderr, "kernel_launch: hipFuncSetAttribute failed\n"); grid = -1; return; }
        int dev = 0, cus = 0, per_cu = 0; hipGetDevice(&dev); hipDeviceGetAttribute(&cus, hipDeviceAttributeMultiprocessorCount, dev);
        hipOccupancyMaxActiveBlocksPerMultiprocessor(&per_cu, (const void*)mega_fwd, NTHR, LDS_BYTES);
        if (per_cu < 1) { fprintf(stderr, "kernel_launch: occupancy query says %d blocks per CU\n", per_cu); }
        (void)hipGetLastError();
        grid = cus;
        if (grid != 256) fprintf(stderr, "kernel_launch: note: %d CUs\n", grid);
    }
    if (grid < 0) return;
    hipMemsetAsync((char*)d_ws + WS_CTL, 0, CTL_BYTES, stream);
    Args a{};
    a.x = (const float*)d_in[0]; a.w_in = (const float*)d_in[1]; a.conv_w = (const float*)d_in[2]; a.w_out = (const float*)d_in[3]; a.ln1_g = (const float*)d_in[4]; a.ln1_b = (const float*)d_in[5];
    a.w_up = (const float*)d_in[6]; a.ffn_conv_w = (const float*)d_in[7]; a.w_down = (const float*)d_in[8]; a.ln2_g = (const float*)d_in[9]; a.ln2_b = (const float*)d_in[10]; a.rel_bias = (const float*)d_in[11];
    a.out = (float*)d_out; a.ws = (unsigned char*)d_ws;
#if MK_PER_PHASE
    for (int p = 0; p < N_PHASES; ++p) { a.ph_lo = p; a.ph_hi = p + 1; hipLaunchKernelGGL(mega_fwd, dim3(grid), dim3(NTHR), LDS_BYTES, stream, a); }
#else
    a.ph_lo = 0; a.ph_hi = N_PHASES + (DUP_P >= 0 ? 1 : 0);
    void* kargs[] = {&a};
    hipError_t e = hipLaunchCooperativeKernel((const void*)mega_fwd, dim3(grid), dim3(NTHR), kargs, LDS_BYTES, stream);
    if (e != hipSuccess) fprintf(stderr, "kernel_launch: cooperative launch failed: %s (grid %d)\n", hipGetErrorString(e), grid);
#endif
}
```
